# Optimizing an MI355X kernel written in HIP

```python
import jax
import jax.numpy as jnp
from jax import lax
import numpy as np


D_MODEL = 1024
BATCH = 8
SEQ = 4096
DEPTH = 2

N_MIXERS = 4
GROUP_W = D_MODEL // N_MIXERS
N_GROUP_HEADS = 4
HEAD_DIM = GROUP_W // N_GROUP_HEADS
ROPE_BASE = 10000.0
RET_CHUNK = 64
RWKV_DECAY_LORA = D_MODEL // 16
RWKV_AAA_LORA = D_MODEL // 16
RWKV_GATE_LORA = D_MODEL // 8
RWKV_GN_EPS = 64e-5
CONV_W = 4
CONV_PAD_LEFT = CONV_W // 2
RGLRU_C = 8.0
GLA_KDIM = GROUP_W // 2
GLA_HEAD_K = GLA_KDIM // N_GROUP_HEADS
GLA_GATE_LORA = 16
GLA_TAU = 16.0
GLA_CHUNK = 64
N_EXPERTS = 16
EC_CAPACITY_FACTOR = 2
D_EXPERT = D_MODEL
NORM_EPS = 1e-6

SPLIT_SIZES = (
    GROUP_W, GROUP_W, GROUP_W, GROUP_W,
    GROUP_W, GROUP_W, GROUP_W,
    RWKV_DECAY_LORA, RWKV_AAA_LORA, RWKV_GATE_LORA,
    GROUP_W, GROUP_W,
    GLA_KDIM, GLA_KDIM, GROUP_W, GROUP_W, GLA_GATE_LORA,
)
IN_COLS = sum(SPLIT_SIZES)
SPLIT_POINTS = tuple(sum(SPLIT_SIZES[:i + 1]) for i in range(len(SPLIT_SIZES) - 1))

kernel_name = "hybrid_parallel_heads_ec_moe_encoder"


def _rmsnorm(x, w):
    xf = x.astype(jnp.float32)
    xf = xf * lax.rsqrt(jnp.mean(xf * xf, axis=-1, keepdims=True) + NORM_EPS)
    return (xf * w.astype(jnp.float32)).astype(x.dtype)


def _head_norm(y, w, center, eps=NORM_EPS):
    yf = y.astype(jnp.float32)
    if center:
        yf = yf - jnp.mean(yf, axis=-1, keepdims=True)
    yf = yf * lax.rsqrt(jnp.mean(yf * yf, axis=-1, keepdims=True) + eps)
    return yf * w.reshape(y.shape[-2], y.shape[-1])


def _heads(z, d):
    return z.reshape(z.shape[0], z.shape[1], -1, d)


def _flip(z):
    return jnp.flip(z, axis=1)


def _rotary(x, positions):
    d = x.shape[-1]
    inv = jnp.power(ROPE_BASE, -jnp.arange(0, d, 2, dtype=jnp.float32) / d)
    ang = positions.astype(jnp.float32)[..., None] * inv
    cos = jnp.cos(ang)[:, :, None, :]
    sin = jnp.sin(ang)[:, :, None, :]
    x1, x2 = x[..., : d // 2], x[..., d // 2:]
    return jnp.concatenate([x1 * cos - x2 * sin, x1 * sin + x2 * cos], axis=-1)


def _retention_chunked(q, k, v, log_gamma):
    B, T, H, d = q.shape
    C = RET_CHUNK
    n = T // C
    qc, kc, vc = (z.reshape(B, n, C, H, d) for z in (q, k, v))
    lg = log_gamma.astype(jnp.float32)
    idx = jnp.arange(C, dtype=jnp.float32)
    rel = idx[:, None] - idx[None, :]
    dmask = jnp.where(rel >= 0, jnp.exp(lg[:, None, None] * jnp.maximum(rel, 0.0)), 0.0)
    scores = jnp.einsum('bnihd,bnjhd->bnhij', qc, kc) * dmask
    y_intra = jnp.einsum('bnhij,bnjhe->bnihe', scores, vc)
    zeta = jnp.exp(lg[:, None] * (C - 1 - idx)[None, :])
    kv = jnp.einsum('bnjhd,hj,bnjhe->bnhde', kc, zeta, vc)
    chunk_decay = jnp.exp(lg * C)[:, None, None]

    def step(state, kv_i):
        return state * chunk_decay + kv_i, state

    _, prev = lax.scan(step, jnp.zeros((B, H, d, d), kv.dtype), jnp.moveaxis(kv, 1, 0))
    prev = jnp.moveaxis(prev, 0, 1)
    xi = jnp.exp(lg[:, None] * (idx + 1.0)[None, :])
    y_cross = jnp.einsum('bnihd,bnhde,hi->bnihe', qc, prev, xi)
    return (y_intra + y_cross).reshape(B, T, H, d)


def _retention_group(q, k, v, g, positions, log_decay, gn_w):
    B, T, _ = q.shape
    qh = _rotary(_heads(q, HEAD_DIM), positions)
    kh = _rotary(_heads(k, HEAD_DIM), positions) * (HEAD_DIM ** -0.5)
    vh = _heads(v, HEAD_DIM)
    y = _retention_chunked(qh, kh, vh, log_decay[0]) + _flip(
        _retention_chunked(_flip(qh), _flip(kh), _flip(vh), log_decay[1]))
    return _head_norm(y, gn_w, center=True).reshape(B, T, GROUP_W) * jax.nn.silu(g)


def _token_shift(z, mu):
    prev = jnp.pad(z, ((0, 0), (1, 0), (0, 0)))[:, :-1]
    return z + mu * (prev - z)


def _rwkv7_direction(r, k, v, xw, xa, mu_rkv, mu_w, mu_a, w0, w_up, a0, a_up, k_k, k_a, r_k):
    B, T, _ = r.shape
    r = _token_shift(r, mu_rkv[0])
    k = _token_shift(k, mu_rkv[1])
    v = _token_shift(v, mu_rkv[2])
    xw = _token_shift(xw, mu_w)
    xa = _token_shift(xa, mu_a)
    w_log = -jax.nn.softplus(-(w0 + jnp.tanh(xw) @ w_up)) - 0.5
    decay = jnp.exp(-jnp.exp(w_log))
    a = jax.nn.sigmoid(a0 + xa @ a_up)
    kk = _heads(k * k_k, HEAD_DIM)
    kk = kk / jnp.maximum(jnp.sqrt(jnp.sum(kk * kk, axis=-1, keepdims=True)), 1e-12)
    k = k * (1.0 + (a - 1.0) * k_a)
    r_h, k_h, v_h, w_h, a_h = (_heads(z, HEAD_DIM) for z in (r, k, v, decay, a))

    def step(S, inp):
        r_t, w_t, k_t, v_t, kk_t, a_t = inp
        sa = jnp.einsum('bhvk,bhk->bhv', S, -kk_t)
        S = (S * w_t[:, :, None, :] + sa[..., None] * (kk_t * a_t)[:, :, None, :]
             + v_t[..., None] * k_t[:, :, None, :])
        return S, jnp.einsum('bhvk,bhk->bhv', S, r_t)

    xs = tuple(jnp.moveaxis(z, 1, 0) for z in (r_h, w_h, k_h, v_h, kk, a_h))
    _, y = lax.scan(step, jnp.zeros((B, N_GROUP_HEADS, HEAD_DIM, HEAD_DIM), r.dtype), xs)
    y = jnp.moveaxis(y, 0, 1)
    bonus = jnp.sum(r_h * k_h * r_k, axis=-1, keepdims=True) * v_h
    return y, bonus


def _rwkv7_group(r, k, v, xw, xa, xg, mu_rkv, mu_w, mu_a, w0, w_up, a0, a_up, g_up,
                 k_k, k_a, r_k, gn_w):
    B, T, _ = r.shape
    y_f, b_f = _rwkv7_direction(r, k, v, xw, xa, mu_rkv, mu_w, mu_a,
                                w0[0], w_up[0], a0[0], a_up[0], k_k, k_a, r_k)
    y_b, b_b = _rwkv7_direction(_flip(r), _flip(k), _flip(v), _flip(xw), _flip(xa), mu_rkv, mu_w, mu_a,
                                w0[1], w_up[1], a0[1], a_up[1], k_k, k_a, r_k)
    y = y_f + _flip(y_b)
    bonus = b_f + _flip(b_b)
    o = (_head_norm(y, gn_w, center=True, eps=RWKV_GN_EPS) + bonus).reshape(B, T, GROUP_W)
    return o * (jax.nn.sigmoid(xg) @ g_up)


def _conv_centred(x, w, b):
    T = x.shape[1]
    xp = jnp.pad(x, ((0, 0), (CONV_PAD_LEFT, CONV_W - 1 - CONV_PAD_LEFT), (0, 0)))
    return sum(xp[:, j:j + T] * w[j] for j in range(CONV_W)) + b


def _lin_comb(left, right):
    a1, b1 = left
    a2, b2 = right
    return a1 * a2, a2 * b1 + b2


def _rglru_group(xr, gate, conv_w, conv_b, gate_w, gate_b, lam):
    B, T, _ = xr.shape
    xc = _conv_centred(xr, conv_w, conv_b)
    xh = _heads(xc, HEAD_DIM)

    def direction(dirn, reverse):
        gx = jnp.einsum('bthd,ghde->gbthe', xh, gate_w[dirn]).reshape(2, B, T, GROUP_W)
        gx = gx + gate_b[dirn][:, None, None, :]
        rec_gate = jax.nn.sigmoid(gx[0])
        in_gate = jax.nn.sigmoid(gx[1])
        log_a = -RGLRU_C * rec_gate * jax.nn.softplus(-lam[dirn])
        a = jnp.exp(log_a)
        bx = jnp.sqrt(-jnp.expm1(2.0 * log_a)) * (in_gate * xc)
        _, h = lax.associative_scan(_lin_comb, (a, bx), axis=1, reverse=reverse)
        return h

    h = direction(0, False) + direction(1, True)
    return h * jax.nn.gelu(gate)


def _gla_chunked(q, k, v, log_alpha):
    B, T, H, dk = q.shape
    dv = v.shape[-1]
    C = GLA_CHUNK
    n = T // C
    q, k, log_alpha = (z.reshape(B, n, C, H, dk) for z in (q, k, log_alpha))
    v = v.reshape(B, n, C, H, dv)
    bcum = jnp.cumsum(log_alpha, axis=2)
    b_last = bcum[:, :, -1:]
    q_dec = q * jnp.exp(bcum)
    k_dec = k * jnp.exp(-bcum)
    lower = jnp.tril(jnp.ones((C, C), dtype=bool))
    scores = jnp.where(lower, jnp.einsum('bnihk,bnjhk->bnhij', q_dec, k_dec), 0.0)
    y_intra = jnp.einsum('bnhij,bnjhv->bnihv', scores, v)
    kv = jnp.einsum('bnjhk,bnjhv->bnhkv', k * jnp.exp(b_last - bcum), v)
    chunk_decay = jnp.exp(b_last[:, :, 0])

    def step(S, inp):
        dec, kv_i = inp
        return S * dec[..., None] + kv_i, S

    _, s_prev = lax.scan(step, jnp.zeros((B, H, dk, dv), kv.dtype),
                         (jnp.moveaxis(chunk_decay, 1, 0), jnp.moveaxis(kv, 1, 0)))
    y_cross = jnp.einsum('bnihk,bnhkv->bnihv', q_dec, jnp.moveaxis(s_prev, 0, 1))
    return (y_intra + y_cross).reshape(B, T, H, dv)


def _gla_group(q, k, v, og, xa, alpha_up, alpha_b, gn_w):
    B, T, _ = q.shape
    qh = _heads(q, GLA_HEAD_K) * (GLA_HEAD_K ** -0.5)
    kh = _heads(k, GLA_HEAD_K)
    vh = _heads(v, HEAD_DIM)
    la_f = _heads(jax.nn.log_sigmoid(xa @ alpha_up[0] + alpha_b[0]) / GLA_TAU, GLA_HEAD_K)
    la_b = _heads(jax.nn.log_sigmoid(xa @ alpha_up[1] + alpha_b[1]) / GLA_TAU, GLA_HEAD_K)
    y = _gla_chunked(qh, kh, vh, la_f) + _flip(
        _gla_chunked(_flip(qh), _flip(kh), _flip(vh), _flip(la_b)))
    return _head_norm(y, gn_w, center=False).reshape(B, T, GROUP_W) * jax.nn.silu(og)


def _expert_choice_ffn(x, router_w, router_b, w_gate, w_up, w_down):
    B, T, D = x.shape
    cap = EC_CAPACITY_FACTOR * T // N_EXPERTS
    logits = jnp.einsum('btd,de->bte', x, router_w) + router_b
    aff = jax.nn.softmax(logits.astype(jnp.float32), axis=-1)
    gates, idx = lax.top_k(jnp.swapaxes(aff, 1, 2), cap)
    bidx = jnp.arange(B)[:, None, None]
    xs = x[bidx, idx]
    hid = jax.nn.silu(jnp.einsum('becd,edf->becf', xs, w_gate)) * jnp.einsum('becd,edf->becf', xs, w_up)
    out = jnp.einsum('becf,efd->becd', hid, w_down) * gates[..., None].astype(x.dtype)
    return jnp.zeros_like(x).at[bidx, idx].add(out.astype(x.dtype))


def setup_inputs(seed: int = 0) -> dict:
    key = jax.random.key(seed)
    ks = iter(jax.random.split(key, 40))
    f32 = jnp.float32
    L, D, W, H, hd = DEPTH, D_MODEL, GROUP_W, N_GROUP_HEADS, HEAD_DIM

    def normal(shape, scale):
        return scale * jax.random.normal(next(ks), shape, f32)

    def gain(shape):
        return 1.0 + normal(shape, 0.02)

    def uniform(shape, lo=0.0, hi=1.0):
        return jax.random.uniform(next(ks), shape, f32, lo, hi)

    x = normal((BATCH, SEQ, D), 1.0)
    positions = jnp.broadcast_to(jnp.arange(SEQ, dtype=jnp.int32), (BATCH, SEQ))
    norm_mix = gain((L, D))
    w_in = normal((L, D, IN_COLS), D ** -0.5)
    w_out = normal((L, D, D), D ** -0.5)
    base = jnp.log1p(-jnp.exp2(-5.0 - jnp.arange(H, dtype=f32)))
    ret_log_decay = base * (1.0 + normal((L, 2, H), 0.05))
    ret_gn = gain((L, W))
    rwkv_mu_rkv = uniform((L, 3, W))
    rwkv_mu_w = uniform((L, RWKV_DECAY_LORA))
    rwkv_mu_a = uniform((L, RWKV_AAA_LORA))
    ramp = jnp.linspace(0.0, 1.0, W, dtype=f32)
    rwkv_w0 = -6.0 + 5.0 * ramp ** 1.5 + normal((L, 2, W), 0.1)
    rwkv_w_up = normal((L, 2, RWKV_DECAY_LORA, W), 0.5 * RWKV_DECAY_LORA ** -0.5)
    rwkv_a0 = normal((L, 2, W), 0.1)
    rwkv_a_up = normal((L, 2, RWKV_AAA_LORA, W), 0.5 * RWKV_AAA_LORA ** -0.5)
    rwkv_g_up = normal((L, RWKV_GATE_LORA, W), RWKV_GATE_LORA ** -0.5)
    rwkv_k_k = 0.85 + normal((L, W), 0.02)
    rwkv_k_a = 1.0 + normal((L, W), 0.02)
    rwkv_r_k = normal((L, H, hd), 0.1)
    rwkv_gn = gain((L, W))
    lru_conv_w = normal((L, CONV_W, W), CONV_W ** -0.5)
    lru_conv_b = normal((L, W), 0.01)
    lru_gate_w = normal((L, 2, 2, H, hd, hd), hd ** -0.5)
    lru_gate_b = normal((L, 2, 2, W), 0.01)
    a_init = uniform((L, 2, W), 0.9, 0.999) ** (1.0 / RGLRU_C)
    lru_lambda = jnp.log(a_init) - jnp.log1p(-a_init)
    gla_alpha_up = normal((L, 2, GLA_GATE_LORA, GLA_KDIM), GLA_GATE_LORA ** -0.5)
    gla_alpha_b = 1.0 + 2.0 * uniform((L, 2, GLA_KDIM))
    gla_gn = gain((L, W))
    norm_ffn = gain((L, D))
    router_w = normal((L, D, N_EXPERTS), D ** -0.5)
    router_b = normal((L, N_EXPERTS), 0.01)
    exp_w_gate = normal((L, N_EXPERTS, D, D_EXPERT), D ** -0.5)
    exp_w_up = normal((L, N_EXPERTS, D, D_EXPERT), D ** -0.5)
    exp_w_down = normal((L, N_EXPERTS, D_EXPERT, D), D_EXPERT ** -0.5)
    norm_final = gain((D,))
    return {
        "x": x, "positions": positions, "norm_mix": norm_mix, "w_in": w_in, "w_out": w_out,
        "ret_log_decay": ret_log_decay, "ret_gn": ret_gn,
        "rwkv_mu_rkv": rwkv_mu_rkv, "rwkv_mu_w": rwkv_mu_w, "rwkv_mu_a": rwkv_mu_a,
        "rwkv_w0": rwkv_w0, "rwkv_w_up": rwkv_w_up, "rwkv_a0": rwkv_a0, "rwkv_a_up": rwkv_a_up,
        "rwkv_g_up": rwkv_g_up, "rwkv_k_k": rwkv_k_k, "rwkv_k_a": rwkv_k_a, "rwkv_r_k": rwkv_r_k,
        "rwkv_gn": rwkv_gn, "lru_conv_w": lru_conv_w, "lru_conv_b": lru_conv_b,
        "lru_gate_w": lru_gate_w, "lru_gate_b": lru_gate_b, "lru_lambda": lru_lambda,
        "gla_alpha_up": gla_alpha_up, "gla_alpha_b": gla_alpha_b, "gla_gn": gla_gn,
        "norm_ffn": norm_ffn, "router_w": router_w, "router_b": router_b,
        "exp_w_gate": exp_w_gate, "exp_w_up": exp_w_up, "exp_w_down": exp_w_down,
        "norm_final": norm_final,
    }


def reference(x, positions, norm_mix, w_in, w_out, ret_log_decay, ret_gn,
              rwkv_mu_rkv, rwkv_mu_w, rwkv_mu_a, rwkv_w0, rwkv_w_up, rwkv_a0, rwkv_a_up,
              rwkv_g_up, rwkv_k_k, rwkv_k_a, rwkv_r_k, rwkv_gn,
              lru_conv_w, lru_conv_b, lru_gate_w, lru_gate_b, lru_lambda,
              gla_alpha_up, gla_alpha_b, gla_gn,
              norm_ffn, router_w, router_b, exp_w_gate, exp_w_up, exp_w_down, norm_final):
    for l in range(DEPTH):
        h = _rmsnorm(x, norm_mix[l])
        proj = jnp.einsum('btd,dc->btc', h, w_in[l]).astype(jnp.float32)
        (rq, rk, rv, rg, wr, wk, wv, wxw, wxa, wxg, lx, lgate,
         gq, gk, gv, gog, gxa) = jnp.split(proj, SPLIT_POINTS, axis=-1)
        o_ret = _retention_group(rq, rk, rv, rg, positions, ret_log_decay[l], ret_gn[l])
        o_rwkv = _rwkv7_group(wr, wk, wv, wxw, wxa, wxg, rwkv_mu_rkv[l], rwkv_mu_w[l], rwkv_mu_a[l],
                              rwkv_w0[l], rwkv_w_up[l], rwkv_a0[l], rwkv_a_up[l], rwkv_g_up[l],
                              rwkv_k_k[l], rwkv_k_a[l], rwkv_r_k[l], rwkv_gn[l])
        o_lru = _rglru_group(lx, lgate, lru_conv_w[l], lru_conv_b[l], lru_gate_w[l],
                             lru_gate_b[l], lru_lambda[l])
        o_gla = _gla_group(gq, gk, gv, gog, gxa, gla_alpha_up[l], gla_alpha_b[l], gla_gn[l])
        mixed = jnp.concatenate([o_ret, o_rwkv, o_lru, o_gla], axis=-1).astype(x.dtype)
        x = x + jnp.einsum('btc,cd->btd', mixed, w_out[l])
        x = x + _expert_choice_ffn(_rmsnorm(x, norm_ffn[l]), router_w[l], router_b[l],
                                   exp_w_gate[l], exp_w_up[l], exp_w_down[l])
    return _rmsnorm(x, norm_final)
```

```cpp
#include <hip/hip_runtime.h>
#include <stdint.h>
#include <stdio.h>

#ifndef ONE_LAUNCH
#define ONE_LAUNCH 1
#endif

typedef unsigned short bf16_t;
typedef short bf16x8 __attribute__((ext_vector_type(8)));
typedef float f32x4 __attribute__((ext_vector_type(4)));
typedef float f32x2 __attribute__((ext_vector_type(2)));
typedef unsigned u32x4 __attribute__((ext_vector_type(4)));
typedef unsigned u32x2 __attribute__((ext_vector_type(2)));

constexpr int D = 1024, BATCH = 8, SEQ = 4096, NTOK = BATCH * SEQ, DEPTH = 2;
constexpr int INC = 3344;
constexpr int PINC = 3456;
constexpr int C_RQ = 0, C_RK = 256, C_RV = 512, C_RG = 768, C_WR = 1024, C_WK = 1280, C_WV = 1536, C_WXW = 1792, C_WXA = 1856,
              C_WXG = 1920, C_LX = 2048, C_LG = 2304, C_GQ = 2560, C_GK = 2688, C_GV = 2816, C_GOG = 3072, C_GXA = 3328;
constexpr int NE = 16, CAP = 512;
constexpr int NTHREADS = 256;
constexpr int BTHREADS = 512;
#define VB_   (__builtin_amdgcn_readfirstlane((int)(threadIdx.x >> 8)))
#define VBID_ ((int)blockIdx.x + (int)gridDim.x * VB_)
#define NVB_  (2 * (int)gridDim.x)
constexpr int LDS_MAIN = 73728, LDS_BYTES = 2 * LDS_MAIN + 64;

constexpr size_t MiB = 1u << 20;
constexpr size_t WS_CTL = 0;
constexpr size_t WS_WTIN = 1 * MiB;
constexpr size_t WS_WTOUT = 15 * MiB;
constexpr size_t WS_WSMALL = 19 * MiB;
constexpr size_t WS_ROT = 20 * MiB;
constexpr size_t WS_AFF = 28 * MiB;
constexpr size_t WS_IDX = 30 * MiB;
constexpr size_t WS_GATE = 30 * MiB + 256 * 1024;
constexpr size_t WS_BONC = 30 * MiB + 512 * 1024;
constexpr size_t WS_INV = 32 * MiB;
constexpr size_t WS_WTEXP = 34 * MiB;
constexpr size_t WS_HB = 130 * MiB;
constexpr size_t WS_PROJ = 194 * MiB;
constexpr size_t WS_YT = 411 * MiB;
constexpr size_t WS_HID = WS_PROJ;
constexpr size_t WS_OUTB = WS_PROJ + 128 * MiB;
constexpr size_t WS_END = 459 * MiB;
constexpr size_t WS_WA = WS_WTEXP;
constexpr size_t WS_YRW = WS_WTEXP + 64 * MiB;
constexpr size_t WS_SC = WS_AFF;
constexpr int SW_WUP = 0;
constexpr int SW_AUP = 32768;
constexpr int SW_GUP = 65536;
constexpr int SW_LRU = 98304;
constexpr int SW_LAYER = 262144;
constexpr int CW_QUEUE = 16;
constexpr int CW_BAR = 4096;

struct Params {
    const float* in[34];
    float* out;
    unsigned char* ws;
    int phase_lo, phase_hi;
};

__device__ __forceinline__ int opaque_tid() { int t = (threadIdx.x & 255); asm volatile("" : "+v"(t)); return t; }
typedef __bf16 bf16x2v __attribute__((ext_vector_type(2)));
__device__ __forceinline__ unsigned cvt_pk_bf16(float lo, float hi) { const f32x2 f = {lo, hi}; const bf16x2v b = __builtin_convertvector(f, bf16x2v); return __builtin_bit_cast(unsigned, b); }
__device__ __forceinline__ float bf_lo(unsigned u) { return __uint_as_float(u << 16); }
__device__ __forceinline__ float bf_hi(unsigned u) { return __uint_as_float(u & 0xffff0000u); }
__device__ __forceinline__ bf16_t f2bf(float f) { return (bf16_t)(cvt_pk_bf16(f, 0.f) & 0xffffu); }
__device__ __forceinline__ float frcp(float x) { return __builtin_amdgcn_rcpf(x); }
__device__ __forceinline__ float sigmoidf_(float x) { return frcp(1.f + __expf(-x)); }
__device__ __forceinline__ float siluf_(float x) { return x * sigmoidf_(x); }
__device__ __forceinline__ float softplusf_(float x) { return fmaxf(x, 0.f) + __logf(1.f + __expf(-fabsf(x))); }
__device__ __forceinline__ float tanhf_(float x) { float xc = fminf(fmaxf(x, -15.f), 15.f); float t = __expf(2.f * xc); return (t - 1.f) * frcp(t + 1.f); }
__device__ __forceinline__ float geluf_(float x) { return 0.5f * x * (1.f + tanhf_(0.7978845608028654f * (x + 0.044715f * x * x * x))); }
__device__ __forceinline__ void unpack8(const u32x4 v, float* f) {
    f[0] = bf_lo(v.x); f[1] = bf_hi(v.x); f[2] = bf_lo(v.y); f[3] = bf_hi(v.y); f[4] = bf_lo(v.z); f[5] = bf_hi(v.z); f[6] = bf_lo(v.w); f[7] = bf_hi(v.w);
}
__device__ __forceinline__ u32x4 pack8(const float* f) {
    u32x4 v; v.x = cvt_pk_bf16(f[0], f[1]); v.y = cvt_pk_bf16(f[2], f[3]); v.z = cvt_pk_bf16(f[4], f[5]); v.w = cvt_pk_bf16(f[6], f[7]); return v;
}
__device__ __forceinline__ float wave_sum(float v) {
#pragma unroll
    for (int o = 1; o < 64; o <<= 1) v += __shfl_xor(v, o);
    return v;
}
__device__ __forceinline__ float dpp_xor1(float x) { return __int_as_float(__builtin_amdgcn_mov_dpp(__float_as_int(x), 0xB1, 0xF, 0xF, true)); }
__device__ __forceinline__ float dpp_hmirror(float x) { return __int_as_float(__builtin_amdgcn_mov_dpp(__float_as_int(x), 0x141, 0xF, 0xF, true)); }
__device__ __forceinline__ float dpp_xor2(float x) { return __int_as_float(__builtin_amdgcn_mov_dpp(__float_as_int(x), 0x4E, 0xF, 0xF, true)); }
#define MFMA16(a, b, c) __builtin_amdgcn_mfma_f32_16x16x32_bf16((a), (b), (c), 0, 0, 0)
#define LDS_FRAG(base, byteoff) (*(const bf16x8*)((base) + (byteoff)))
__device__ __forceinline__ u32x4 pair_swap16(const u32x2 a, const u32x2 b) {
    const u32x2 r0 = __builtin_amdgcn_permlane16_swap(a.x, b.x, false, false), r1 = __builtin_amdgcn_permlane16_swap(a.y, b.y, false, false);
    return (u32x4){r0.x, r1.x, r0.y, r1.y};
}
__device__ __forceinline__ int swz8(int fq) { return ((fq & 1) << 4) | ((fq >> 1) << 3); }

#define XB_TMO      128
#define XB_XCNT(j)  (256  + 64 * (j))
#define XB_XSUB(j)  (1280 + 64 * (j))
#define XB_XGEN(j)  (2304 + 64 * (j))
#define XB_TOP      3328
#define XB_TOPGEN   3392
#define XB_SPIN_CAP (1u << 22)
__device__ __forceinline__ unsigned xb_ld(unsigned* p) { return __hip_atomic_load(p, __ATOMIC_RELAXED, __HIP_MEMORY_SCOPE_AGENT); }
__device__ __forceinline__ unsigned xb_add(unsigned* p, unsigned v) { return __hip_atomic_fetch_add(p, v, __ATOMIC_RELAXED, __HIP_MEMORY_SCOPE_AGENT); }
__device__ __forceinline__ unsigned xb_xcc_id() { return (unsigned)__builtin_amdgcn_s_getreg((3 << 11) | 20) & 0xFu; }
#define XB_SPIN(cond, bar) do { unsigned _sp = 0; while (cond) { __builtin_amdgcn_s_sleep(1); \
    if ((++_sp & 255u) == 0u) { if (xb_ld(&(bar)[XB_TMO])) break; if (_sp > XB_SPIN_CAP) { atomicAdd(&(bar)[XB_TMO], 1u); break; } } } } while (0)
struct XcdBarrier { unsigned* bar; unsigned x; volatile unsigned* st; };
__device__ __forceinline__ XcdBarrier xcd_barrier_post(unsigned* bar, volatile unsigned* st) {
    XcdBarrier b; b.bar = bar; b.x = xb_xcc_id(); b.st = st;
    if (threadIdx.x == 0) (void)xb_add(&bar[XB_XCNT(b.x)], 1u);
    return b;
}
__device__ __forceinline__ void xcd_barrier_complete(unsigned* bar, unsigned x, unsigned& nloc, unsigned& nx) {
    const unsigned G = gridDim.x;
    unsigned sum, cnt, mine, sp = 0u;
    for (;;) {
        sum = 0u; cnt = 0u; mine = 0u;
#pragma unroll
        for (unsigned j = 0; j < 16; ++j) { const unsigned c = xb_ld(&bar[XB_XCNT(j)]); sum += c; cnt += (c > 0u) ? 1u : 0u; mine = (j == x) ? c : mine; }
        if (sum == G) break;
        __builtin_amdgcn_s_sleep(1);
        if ((++sp & 255u) == 0u) { if (xb_ld(&bar[XB_TMO])) break; if (sp > XB_SPIN_CAP) { atomicAdd(&bar[XB_TMO], 1u); break; } }
    }
    nloc = mine > 0u ? mine : 1u; nx = cnt > 0u ? cnt : 1u;
}
__device__ __forceinline__ void xcd_barrier(const XcdBarrier& b) {
    asm volatile("s_waitcnt vmcnt(0)" ::: "memory");
    __syncthreads();
    if (threadIdx.x == 0) {
        unsigned* bar = b.bar;
        __builtin_amdgcn_s_waitcnt(0);
        unsigned nloc = b.st[0], nx = b.st[1];
        if (nloc == 0u) { xcd_barrier_complete(bar, b.x, nloc, nx); b.st[0] = nloc; b.st[1] = nx; }
        const unsigned old = xb_add(&bar[XB_XSUB(b.x)], 1u);
        const unsigned gen = old / nloc;
        if (old + 1u == (gen + 1u) * nloc) {
            __builtin_amdgcn_fence(__ATOMIC_RELEASE, "agent");
            asm volatile("s_waitcnt vmcnt(0)" ::: "memory");
            const unsigned og = xb_add(&bar[XB_TOP], 1u);
            const unsigned tg = og / nx;
            if (og + 1u == (tg + 1u) * nx) xb_add(&bar[XB_TOPGEN], 1u);
            else XB_SPIN(xb_ld(&bar[XB_TOPGEN]) == tg, bar);
            __builtin_amdgcn_fence(__ATOMIC_ACQUIRE, "");
            xb_add(&bar[XB_XGEN(b.x)], 1u);
            asm volatile("s_waitcnt vmcnt(0)" ::: "memory");
        } else {
            XB_SPIN(xb_ld(&bar[XB_XGEN(b.x)]) == gen, bar);
            __builtin_amdgcn_fence(__ATOMIC_ACQUIRE, "agent");
            asm volatile("s_waitcnt vmcnt(0)" ::: "memory");
        }
    }
    __syncthreads();
}

#define WSP(T, off) ((T*)(p.ws + (off)))
__device__ __forceinline__ bf16_t* wt_in(const Params& p, int l) { return WSP(bf16_t, WS_WTIN + (size_t)l * 7 * MiB); }
__device__ __forceinline__ bf16_t* wt_out(const Params& p, int l) { return WSP(bf16_t, WS_WTOUT + (size_t)l * 2 * MiB); }
__device__ __forceinline__ bf16_t* wt_small(const Params& p, int l) { return WSP(bf16_t, WS_WSMALL) + (size_t)l * SW_LAYER; }
__device__ __forceinline__ size_t hb_off(size_t tok, int col) { return ((size_t)(col >> 5) * NTOK + tok) * 32 + (col & 31); }
__device__ __forceinline__ size_t hid_off(size_t row, int col) { return ((size_t)(col >> 5) * 65536 + row) * 32 + (col & 31); }
__device__ __forceinline__ bf16_t* yt_buf(const Params& p, int i) { return WSP(bf16_t, WS_YT + (size_t)i * 16 * MiB); }

__device__ __forceinline__ void transpose_tile(const float* __restrict__ src, int lds_, int K, int N, bf16_t* __restrict__ dst, int ldd, int kt, int nt, float* tile, int kb = 0) {
    int tid_ = (threadIdx.x & 255); asm volatile("" : "+v"(tid_)); const int tid = tid_, k0 = kt * 64, n0 = nt * 64;
#pragma unroll
    for (int i = 0; i < 4; ++i) {
        const int r = (tid >> 4) + 16 * i, c = (tid & 15) * 4;
        f32x4 v = {0.f, 0.f, 0.f, 0.f};
        if (k0 + r < K) {
            if (n0 + c + 3 < N) v = *(const f32x4*)(src + (size_t)(k0 + r) * lds_ + n0 + c);
            else { if (n0 + c < N) v.x = src[(size_t)(k0 + r) * lds_ + n0 + c]; if (n0 + c + 1 < N) v.y = src[(size_t)(k0 + r) * lds_ + n0 + c + 1]; if (n0 + c + 2 < N) v.z = src[(size_t)(k0 + r) * lds_ + n0 + c + 2]; }
        }
        tile[r * 65 + c] = v.x; tile[r * 65 + c + 1] = v.y; tile[r * 65 + c + 2] = v.z; tile[r * 65 + c + 3] = v.w;
    }
    __syncthreads();
    {
        const int n = tid >> 2, kc = (tid & 3) * 16;
        if (n0 + n < N) {
            float f[16];
#pragma unroll
            for (int j = 0; j < 16; ++j) f[j] = tile[(kc + j) * 65 + n];
            u32x4 a = pack8(f), b = pack8(f + 8);
            bf16_t* o = kb ? dst + ((size_t)((k0 + kc) >> 5) * kb + n0 + n) * 32 + ((k0 + kc) & 31) : dst + (size_t)(n0 + n) * ldd + k0 + kc;
            *(u32x4*)o = a; *(u32x4*)(o + 8) = b;
        }
    }
    __syncthreads();
}

__device__ __forceinline__ void phase_p0(const Params& p, unsigned char* smem) {
    float* tile = (float*)smem;
    const int bid = VBID_, nb = NVB_;
    constexpr int J_IN = 16 * 53, J_OUT = 256, J_WUP = 8, J_AUP = 8, J_GUP = 8, J_LRU = 16, J_L = J_IN + J_OUT + J_WUP + J_AUP + J_GUP + J_LRU;
    for (int k = 0; k < (2 * J_L + nb - 1) / nb; ++k) {
        const int job = bid + k * nb;
        if (job >= 2 * J_L) { __syncthreads(); __syncthreads(); continue; }
        const int l = job / J_L; int r = job % J_L;
        bf16_t* sw = wt_small(p, l);
        if (r < J_IN) { transpose_tile(p.in[3] + (size_t)l * D * INC, INC, D, INC, wt_in(p, l), D, r / 53, r % 53, tile, INC); continue; } r -= J_IN;
        if (r < J_OUT) { transpose_tile(p.in[4] + (size_t)l * D * D, D, D, D, wt_out(p, l), D, r / 16, r % 16, tile, D); continue; } r -= J_OUT;
        if (r < J_WUP) { const int dir = r / 4; transpose_tile(p.in[11] + (size_t)(l * 2 + dir) * 64 * 256, 256, 64, 256, sw + SW_WUP + dir * 16384, 64, 0, r % 4, tile); continue; } r -= J_WUP;
        if (r < J_AUP) { const int dir = r / 4; transpose_tile(p.in[13] + (size_t)(l * 2 + dir) * 64 * 256, 256, 64, 256, sw + SW_AUP + dir * 16384, 64, 0, r % 4, tile); continue; } r -= J_AUP;
        if (r < J_GUP) { transpose_tile(p.in[14] + (size_t)l * 128 * 256, 256, 128, 256, sw + SW_GUP, 128, r / 4, r % 4, tile); continue; } r -= J_GUP;
        { transpose_tile(p.in[21] + (size_t)(l * 16 + r) * 4096, 64, 64, 64, sw + SW_LRU + r * 4096, 64, 0, 0, tile); }
    }
    const int* pos = (const int*)p.in[1];
    f32x2* rot = WSP(f32x2, WS_ROT);
    for (int i = bid * NTHREADS + opaque_tid(); i < NTOK * 32; i += nb * NTHREADS) {
        const int tok = i >> 5, j = i & 31;
        const float inv = exp2f(-(float)j * (13.287712379549449f / 32.f));
        const float ang = (float)pos[tok] * inv;
        float s, c; sincosf(ang, &s, &c);
        rot[i] = (f32x2){c, s};
    }
}

__device__ __forceinline__ void conv_expert_items(const Params& p, int l, int part, unsigned char* smem) {
    float* tile = (float*)smem;
    bf16_t* dstbase = WSP(bf16_t, WS_WTEXP);
    const int nitems = (part == 0 ? 32 : 16) * 256;
    int tid_ = (threadIdx.x & 255); asm volatile("" : "+v"(tid_)); const int tid = tid_;
    const int r0 = tid >> 4, c0 = (tid & 15) * 4;
    const int n = tid >> 2, kc = (tid & 3) * 16;
    f32x4 v[4];
#define CONV_SRC(it_) (p.in[30 + ((part == 0) ? (((it_) >> 8) & 1) : 2)] + ((size_t)l * NE + ((part == 0) ? ((it_) >> 9) : ((it_) >> 8))) * D * D + (size_t)((((it_) & 255) >> 4) * 64) * D + ((it_) & 15) * 64)
#define CONV_LOAD(it_) do { const float* s_ = CONV_SRC(it_); _Pragma("unroll") for (int i = 0; i < 4; ++i) v[i] = *(const f32x4*)(s_ + (size_t)(r0 + 16 * i) * D + c0); } while (0)
    const int last = nitems - 1;
    { const int itf = VBID_ < nitems ? VBID_ : last; CONV_LOAD(itf); }
    __syncthreads();
    for (int k = 0; k < (nitems + NVB_ - 1) / NVB_; ++k) {
        const int itr = VBID_ + k * NVB_, it = itr < nitems ? itr : last;
        const int mi = it >> 8, t = it & 255;
        const int e = (part == 0) ? (mi >> 1) : mi, which = (part == 0) ? (mi & 1) : 2;
#pragma unroll
        for (int i = 0; i < 4; ++i) { const int r = r0 + 16 * i; tile[r * 65 + c0] = v[i].x; tile[r * 65 + c0 + 1] = v[i].y; tile[r * 65 + c0 + 2] = v[i].z; tile[r * 65 + c0 + 3] = v[i].w; }
        __syncthreads();
        if (k + 1 < (nitems + NVB_ - 1) / NVB_) { const int itn = itr + NVB_ < nitems ? itr + NVB_ : last; CONV_LOAD(itn); }
        {
            float f[16];
#pragma unroll
            for (int j = 0; j < 16; ++j) f[j] = tile[(kc + j) * 65 + n];
            const int k0 = (t >> 4) * 64, n0 = (t & 15) * 64;
            bf16_t* o = dstbase + (size_t)(e * 3 + which) * D * D + ((size_t)((k0 + kc) >> 5) * D + n0 + n) * 32 + ((k0 + kc) & 31);
            *(u32x4*)o = pack8(f); *(u32x4*)(o + 8) = pack8(f + 8);
        }
        __syncthreads();
    }
#undef CONV_LOAD
#undef CONV_SRC
}

__device__ __forceinline__ void phase_norm(const Params& p, int mode, const float* __restrict__ wgt, int l, unsigned char* smem) {
    int tid_ = (threadIdx.x & 255); asm volatile("" : "+v"(tid_)); const int tid = tid_, lane = tid & 63, wave = tid >> 6;
    float* rw = (float*)smem;
    if (mode == 3) {
        const float* rsrc = p.in[28] + (size_t)l * D * NE;
        for (int i = tid; i < D * NE; i += NTHREADS) {
            const int d = i >> 4, e = i & 15;
            const int j = d >> 8, ln = (d & 255) >> 2, ii = d & 3;
            rw[((j * 4 + ii) * 16 + e) * 64 + ln] = rsrc[i];
        }
        __syncthreads();
    }
    const float* xin = (mode == 0) ? p.in[0] : p.out;
    bf16_t* HB = WSP(bf16_t, WS_HB);
    const int* INV = WSP(int, WS_INV);
    const bf16_t* OUTB = WSP(bf16_t, WS_OUTB);
    const int gw = VBID_ * 4 + wave, ngw = NVB_ * 4;
    for (int row = gw; row < NTOK; row += ngw) {
        f32x4 v[4];
#pragma unroll
        for (int j = 0; j < 4; ++j) v[j] = *(const f32x4*)(xin + (size_t)row * D + 4 * lane + 256 * j);
        if (mode == 1 || mode == 2) {
            const int b = row >> 12;
            const int myinv = (lane < 16) ? INV[(size_t)row * 16 + lane] : -1;
#pragma unroll 1
            for (int e = 0; e < 16; ++e) {
                const int slot = __shfl(myinv, e);
                if (slot >= 0) {
                    const bf16_t* orow = OUTB + ((size_t)(b * 16 + e) * CAP + slot) * D;
#pragma unroll
                    for (int j = 0; j < 4; ++j) {
                        const u32x2 o = *(const u32x2*)(orow + 4 * lane + 256 * j);
                        v[j].x += bf_lo(o.x); v[j].y += bf_hi(o.x); v[j].z += bf_lo(o.y); v[j].w += bf_hi(o.y);
                    }
                }
            }
            if (mode == 1) {
#pragma unroll
                for (int j = 0; j < 4; ++j) *(f32x4*)(p.out + (size_t)row * D + 4 * lane + 256 * j) = v[j];
            }
        }
        float ss = 0.f;
#pragma unroll
        for (int j = 0; j < 4; ++j) ss += v[j].x * v[j].x + v[j].y * v[j].y + v[j].z * v[j].z + v[j].w * v[j].w;
        ss = wave_sum(ss);
        const float rstd = rsqrtf(ss * (1.f / D) + 1e-6f);
#pragma unroll
        for (int j = 0; j < 4; ++j) { const f32x4 w = *(const f32x4*)(wgt + 4 * lane + 256 * j); v[j] = v[j] * rstd * w; }
        if (mode == 2) {
#pragma unroll
            for (int j = 0; j < 4; ++j) *(f32x4*)(p.out + (size_t)row * D + 4 * lane + 256 * j) = v[j];
        } else {
#pragma unroll
            for (int j = 0; j < 4; ++j) { u32x2 o; o.x = cvt_pk_bf16(v[j].x, v[j].y); o.y = cvt_pk_bf16(v[j].z, v[j].w); *(u32x2*)(HB + hb_off(row, 4 * lane + 256 * j)) = o; }
        }
        if (mode == 3) {
            float lg[16];
#pragma unroll
            for (int e = 0; e < 16; ++e) lg[e] = 0.f;
#pragma unroll
            for (int j = 0; j < 4; ++j) {
                const float xv[4] = {v[j].x, v[j].y, v[j].z, v[j].w};
#pragma unroll
                for (int ii = 0; ii < 4; ++ii) {
#pragma unroll
                    for (int e = 0; e < 16; ++e) lg[e] += xv[ii] * rw[((j * 4 + ii) * 16 + e) * 64 + lane];
                    __builtin_amdgcn_sched_barrier(0);
                }
            }
            float mx = -1e30f;
#pragma unroll
            for (int e = 0; e < 16; ++e) { lg[e] = wave_sum(lg[e]) + p.in[29][l * NE + e]; mx = fmaxf(mx, lg[e]); }
            float sum = 0.f;
#pragma unroll
            for (int e = 0; e < 16; ++e) { lg[e] = __expf(lg[e] - mx); sum += lg[e]; }
            const float inv = 1.f / sum;
            float mine = 0.f;
#pragma unroll
            for (int e = 0; e < 16; ++e) mine = (lane == e) ? lg[e] * inv : mine;
            if (lane < 16) { const int b = row >> 12, t = row & 4095; WSP(float, WS_AFF)[((size_t)b * NE + lane) * SEQ + t] = mine; }
        }
    }
}

__device__ __forceinline__ void phase_ffnnorm_router(const Params& p, int l, unsigned char* smem) {
    int tid_ = (threadIdx.x & 255); asm volatile("" : "+v"(tid_)); const int tid = tid_, lane = tid & 63, wave = tid >> 6, fr = lane & 15, fq = lane >> 4;
    constexpr int PR = 2064;
    unsigned char* RWh = smem; unsigned char* RWl = smem + 16 * PR;
    const float* wgt = p.in[27] + l * D;
    {
        const float* rsrc = p.in[28] + (size_t)l * D * NE;
        for (int i = tid; i < D * NE; i += NTHREADS) {
            const int k = i >> 4, e = i & 15;
            const float v = rsrc[i] * wgt[k];
            const unsigned hb = cvt_pk_bf16(v, 0.f) & 0xffffu;
            const float hf = __uint_as_float(hb << 16);
            *(bf16_t*)(RWh + e * PR + k * 2) = (bf16_t)hb;
            *(bf16_t*)(RWl + e * PR + k * 2) = (bf16_t)(cvt_pk_bf16(v - hf, 0.f) & 0xffffu);
        }
        __syncthreads();
    }
    bf16_t* HB = WSP(bf16_t, WS_HB);
    float* AFF = WSP(float, WS_AFF);
    const int gw = VBID_ * 4 + wave, ngw = NVB_ * 4;
    for (int grp = gw; grp < NTOK / 16; grp += ngw) {
        const size_t row = (size_t)grp * 16 + fr;
        const float* xr = p.out + row * D + 8 * fq;
        f32x4 acc = {0.f, 0.f, 0.f, 0.f};
        float ss = 0.f;
#pragma unroll 4
        for (int ks = 0; ks < 32; ++ks) {
            const f32x4 x0 = *(const f32x4*)(xr + 32 * ks), x1 = *(const f32x4*)(xr + 32 * ks + 4);
            const float xv[8] = {x0.x, x0.y, x0.z, x0.w, x1.x, x1.y, x1.z, x1.w};
            unsigned hp[4], lp[4];
#pragma unroll
            for (int j = 0; j < 4; ++j) {
                ss += xv[2 * j] * xv[2 * j] + xv[2 * j + 1] * xv[2 * j + 1];
                hp[j] = cvt_pk_bf16(xv[2 * j], xv[2 * j + 1]);
                lp[j] = cvt_pk_bf16(xv[2 * j] - bf_lo(hp[j]), xv[2 * j + 1] - bf_hi(hp[j]));
            }
            const u32x4 ahu = {hp[0], hp[1], hp[2], hp[3]}, alu = {lp[0], lp[1], lp[2], lp[3]};
            const bf16x8 ah = __builtin_bit_cast(bf16x8, ahu), al = __builtin_bit_cast(bf16x8, alu);
            const bf16x8 bh = LDS_FRAG(RWh, fr * PR + (32 * ks + 8 * fq) * 2), bl = LDS_FRAG(RWl, fr * PR + (32 * ks + 8 * fq) * 2);
            acc = MFMA16(bh, ah, acc); acc = MFMA16(bh, al, acc); acc = MFMA16(bl, ah, acc);
        }
        ss += __shfl_xor(ss, 16); ss += __shfl_xor(ss, 32);
        const float rstd = rsqrtf(ss * (1.f / D) + 1e-6f);
        float lg[4], mx = -1e30f;
#pragma unroll
        for (int r = 0; r < 4; ++r) { lg[r] = acc[r] * rstd + p.in[29][l * NE + 4 * fq + r]; mx = fmaxf(mx, lg[r]); }
        mx = fmaxf(mx, __shfl_xor(mx, 16)); mx = fmaxf(mx, __shfl_xor(mx, 32));
        float sum = 0.f;
#pragma unroll
        for (int r = 0; r < 4; ++r) { lg[r] = __expf(lg[r] - mx); sum += lg[r]; }
        sum += __shfl_xor(sum, 16); sum += __shfl_xor(sum, 32);
        const float inv = 1.f / sum;
        {
            const int b = (int)(row >> 12), t = (int)(row & 4095);
#pragma unroll
            for (int r = 0; r < 4; ++r) AFF[((size_t)b * NE + 4 * fq + r) * SEQ + t] = lg[r] * inv;
        }
        bf16_t* hr = HB + row * 32 + 8 * fq;
#pragma unroll 4
        for (int ks = 0; ks < 32; ++ks) {
            const f32x4 x0 = *(const f32x4*)(xr + 32 * ks), x1 = *(const f32x4*)(xr + 32 * ks + 4);
            const f32x4 w0 = *(const f32x4*)(wgt + 32 * ks + 8 * fq), w1 = *(const f32x4*)(wgt + 32 * ks + 8 * fq + 4);
            u32x4 o;
            o.x = cvt_pk_bf16(x0.x * rstd * w0.x, x0.y * rstd * w0.y); o.y = cvt_pk_bf16(x0.z * rstd * w0.z, x0.w * rstd * w0.w);
            o.z = cvt_pk_bf16(x1.x * rstd * w1.x, x1.y * rstd * w1.y); o.w = cvt_pk_bf16(x1.z * rstd * w1.z, x1.w * rstd * w1.w);
            *(u32x4*)(hr + (size_t)ks * NTOK * 32) = o;
        }
    }
}

__device__ __forceinline__ void phase_topk(const Params& p, unsigned char* smem) {
    int tid_ = threadIdx.x; asm volatile("" : "+v"(tid_)); const int tid = tid_, lane = tid & 63, wave = tid >> 6;
    int* scnt = (int*)smem;
    const float* AFF = WSP(float, WS_AFF);
    int* IDX = WSP(int, WS_IDX); float* GATE = WSP(float, WS_GATE); int* INV = WSP(int, WS_INV);
    for (int be = blockIdx.x; be < BATCH * NE; be += gridDim.x) {
        const int b = be / NE, e = be % NE;
        unsigned key[8];
#pragma unroll
        for (int j = 0; j < 8; ++j) key[j] = __float_as_uint(AFF[(size_t)be * SEQ + j * 512 + tid]);
        unsigned prefix = 0u; int remaining = CAP;
#pragma unroll 1
        for (int bit = 30; bit >= 0; --bit) {
            const unsigned cand = prefix | (1u << bit);
            int c = 0;
#pragma unroll
            for (int j = 0; j < 8; ++j) c += ((key[j] >> bit) == (cand >> bit)) ? 1 : 0;
            c = (int)wave_sum((float)c);
            __syncthreads();
            if (lane == 0) scnt[wave] = c;
            __syncthreads();
            const int tot = scnt[0] + scnt[1] + scnt[2] + scnt[3] + scnt[4] + scnt[5] + scnt[6] + scnt[7];
            if (tot >= remaining) prefix = cand; else remaining -= tot;
        }
        int gt_base = 0, eq_base = 0;
#pragma unroll 1
        for (int j = 0; j < 8; ++j) {
            const bool gt = key[j] > prefix, eq = key[j] == prefix;
            const unsigned long long mg = __ballot(gt), me = __ballot(eq);
            const unsigned long long lower = (lane == 0) ? 0ull : (~0ull >> (64 - lane));
            const int pg = __popcll(mg & lower), pe = __popcll(me & lower);
            __syncthreads();
            if (lane == 0) { scnt[wave] = __popcll(mg); scnt[8 + wave] = __popcll(me); }
            __syncthreads();
            int wg = 0, we = 0, tg = 0, te = 0;
#pragma unroll
            for (int w = 0; w < 8; ++w) { const int a = scnt[w], c2 = scnt[8 + w]; if (w < wave) { wg += a; we += c2; } tg += a; te += c2; }
            const int g_before = gt_base + wg + pg, e_before = eq_base + we + pe;
            const int t = j * 512 + tid;
            int slot = -1;
            if (gt) slot = g_before + min(e_before, remaining);
            else if (eq && e_before < remaining) slot = g_before + e_before;
            if (slot >= 0) { IDX[(size_t)be * CAP + slot] = t; GATE[(size_t)be * CAP + slot] = __uint_as_float(key[j]); }
            INV[((size_t)b * SEQ + t) * 16 + e] = slot;
            gt_base += tg; eq_base += te;
        }
        __syncthreads();
    }
}

enum { G_PROJ = 0, G_OUT = 1, G_MOE1 = 2, G_MOE2 = 3 };
struct GemmJob {
    const bf16_t* A; const bf16_t* B;
    int mode, mt, nt;
    int be, e;
    int l;
};
__device__ __forceinline__ int gswz(int r16) { return (0x78 >> (2 * ((r16 >> 2) & 3))) & 3; }
__device__ __forceinline__ void gemm_tile(const Params& p, const GemmJob& g, unsigned char* smem) {
    int tid_ = threadIdx.x; asm volatile("" : "+v"(tid_)); const int tid = tid_, lane = tid & 63, wave = __builtin_amdgcn_readfirstlane(tid >> 6);
    const int wr = wave >> 2, wc = wave & 3, fr = lane & 15, fq = lane >> 4;
    const int srow = lane >> 2;
    const int csrc = (lane & 3) ^ gswz(srow);
    const bf16_t* aptr[2]; const bf16_t* bptr[2];
    const int* IDX = WSP(int, WS_IDX);
#pragma unroll
    for (int i = 0; i < 2; ++i) {
        const int r = (i * 8 + wave) * 16 + srow;
        size_t arow;
        if (g.mode == G_MOE1) {
            const int wr_ = r >> 7, m = (r >> 4) & 7, f = r & 15;
            arow = (size_t)(m >> 2) * (D * D / 32) + g.nt * 128 + wr_ * 64 + (m & 3) * 16 + f;
            aptr[i] = g.B + arow * 32 + csrc * 8;
            continue;
        }
        else if (g.mode == G_MOE2) arow = (size_t)g.be * CAP + g.mt * 256 + r;
        else arow = (size_t)g.mt * 256 + r;
        aptr[i] = g.A + arow * 32 + csrc * 8;
    }
#pragma unroll
    for (int i = 0; i < 2; ++i) {
        const int r = (i * 8 + wave) * 16 + srow;
        size_t brow;
        if (g.mode == G_MOE1) {
            brow = (size_t)(g.be >> 4) * SEQ + IDX[(size_t)g.be * CAP + g.mt * 256 + r];
            bptr[i] = g.A + brow * 32 + csrc * 8;
            continue;
        }
        else { int c = g.nt * 256 + r; if (g.mode == G_PROJ && c >= INC) c = INC - 1; brow = c; }
        bptr[i] = g.B + brow * 32 + csrc * 8;
    }
    asm volatile("s_waitcnt lgkmcnt(0)" ::: "memory");
    __builtin_amdgcn_s_barrier();
    asm volatile("" ::: "memory");
    f32x4 acc[8][4];
#pragma unroll
    for (int m = 0; m < 8; ++m)
#pragma unroll
        for (int n = 0; n < 4; ++n) acc[m][n] = (f32x4){0.f, 0.f, 0.f, 0.f};
#define G_STAGE(buf, kt) do { _Pragma("unroll") for (int _i = 0; _i < 2; ++_i) \
        __builtin_amdgcn_global_load_lds((const unsigned*)(aptr[_i] + (size_t)(kt) * astep), (unsigned*)(smem + (buf) * 32768 + (_i * 8 + wave) * 1024), 16, 0, 0); \
        _Pragma("unroll") for (int _i = 0; _i < 2; ++_i) \
        __builtin_amdgcn_global_load_lds((const unsigned*)(bptr[_i] + (size_t)(kt) * bstep), (unsigned*)(smem + (buf) * 32768 + 16384 + (_i * 8 + wave) * 1024), 16, 0, 0); } while (0)
    const int bstep = __builtin_amdgcn_readfirstlane((g.mode == G_PROJ ? INC : g.mode == G_MOE1 ? NTOK : D) * 32);
    const int astep = __builtin_amdgcn_readfirstlane((g.mode == G_MOE2 ? 65536 : g.mode == G_MOE1 ? D : NTOK) * 32);
    G_STAGE(0, 0); G_STAGE(1, 1); G_STAGE(2, 2);
    const int coff = (fq ^ gswz(fr)) * 16;
    const int aoff = (wr * 128 + fr) * 64 + coff, boff = 16384 + (wc * 64 + fr) * 64 + coff;
#pragma unroll 1
    for (int t = 0; t < 32; ++t) {
        if (t < 30) asm volatile("s_waitcnt vmcnt(8)" ::: "memory"); else if (t == 30) asm volatile("s_waitcnt vmcnt(4)" ::: "memory"); else asm volatile("s_waitcnt vmcnt(0)" ::: "memory");
        __builtin_amdgcn_s_barrier();
        if (t + 3 < 32) G_STAGE((t + 3) & 3, t + 3);
        const unsigned char* sb = smem + (t & 3) * 32768;
        bf16x8 af[8], bfv[4];
#pragma unroll
        for (int n = 0; n < 4; ++n) bfv[n] = LDS_FRAG(sb, boff + n * 1024);
        af[0] = LDS_FRAG(sb, aoff); af[1] = LDS_FRAG(sb, aoff + 1024);
        __builtin_amdgcn_sched_barrier(0);
#pragma unroll
        for (int gq = 0; gq < 4; ++gq) {
            if (gq < 3) { af[2 * gq + 2] = LDS_FRAG(sb, aoff + (2 * gq + 2) * 1024); af[2 * gq + 3] = LDS_FRAG(sb, aoff + (2 * gq + 3) * 1024); }
            __builtin_amdgcn_sched_barrier(0);
#pragma unroll
            for (int mm = 0; mm < 2; ++mm)
#pragma unroll
                for (int n = 0; n < 4; ++n) acc[2 * gq + mm][n] = (g.mode == G_MOE1) ? MFMA16(af[2 * gq + mm], bfv[n], acc[2 * gq + mm][n]) : MFMA16(bfv[n], af[2 * gq + mm], acc[2 * gq + mm][n]);
            __builtin_amdgcn_sched_barrier(0);
        }
    }
#undef G_STAGE
    if (g.mode == G_PROJ) {
        bf16_t* PROJ = WSP(bf16_t, WS_PROJ);
        if (g.nt < 2) {
            const f32x2* ROT = WSP(f32x2, WS_ROT);
            const float ksc = (g.nt >= 1) ? 0.125f : 1.f;
#pragma unroll
            for (int m = 0; m < 8; ++m) {
                const size_t row = (size_t)g.mt * 256 + wr * 128 + m * 16 + fr;
#pragma unroll
                for (int n = 0; n < 2; ++n) {
                    const f32x4 cs0 = *(const f32x4*)(ROT + row * 32 + n * 16 + fq * 4), cs1 = *(const f32x4*)(ROT + row * 32 + n * 16 + fq * 4 + 2);
                    const float co[4] = {cs0.x, cs0.z, cs1.x, cs1.z}, si[4] = {cs0.y, cs0.w, cs1.y, cs1.w};
#pragma unroll
                    for (int r = 0; r < 4; ++r) {
                        const float x1 = acc[m][n][r], x2 = acc[m][n + 2][r];
                        acc[m][n][r] = (x1 * co[r] - x2 * si[r]) * ksc; acc[m][n + 2][r] = (x1 * si[r] + x2 * co[r]) * ksc;
                    }
                }
            }
        }
        if (g.nt * 256 + wc * 64 < PINC)
#pragma unroll
        for (int m = 0; m < 8; ++m) {
            const size_t row = (size_t)g.mt * 256 + wr * 128 + m * 16 + fr;
            bf16_t* orow = PROJ + row * PINC + g.nt * 256 + wc * 64 + swz8(fq);
#pragma unroll
            for (int n1 = 0; n1 < 2; ++n1) {
                u32x2 a, b;
                a.x = cvt_pk_bf16(acc[m][2 * n1][0], acc[m][2 * n1][1]); a.y = cvt_pk_bf16(acc[m][2 * n1][2], acc[m][2 * n1][3]);
                b.x = cvt_pk_bf16(acc[m][2 * n1 + 1][0], acc[m][2 * n1 + 1][1]); b.y = cvt_pk_bf16(acc[m][2 * n1 + 1][2], acc[m][2 * n1 + 1][3]);
                *(u32x4*)(orow + 32 * n1) = pair_swap16(a, b);
            }
        }
    } else if (g.mode == G_OUT) {
        const float* xin = (g.l == 0) ? p.in[0] : p.out;
#pragma unroll
        for (int m = 0; m < 8; ++m) {
            const size_t row = (size_t)g.mt * 256 + wr * 128 + m * 16 + fr;
#pragma unroll
            for (int n = 0; n < 4; ++n) {
                const int col = g.nt * 256 + wc * 64 + n * 16 + fq * 4;
                const f32x4 x = *(const f32x4*)(xin + row * D + col);
                *(f32x4*)(p.out + row * D + col) = x + acc[m][n];
            }
            __builtin_amdgcn_sched_barrier(0);
        }
    } else if (g.mode == G_MOE1) {
        bf16_t* HID = WSP(bf16_t, WS_HID);
#pragma unroll
        for (int n = 0; n < 4; ++n) {
            const size_t row = (size_t)g.be * CAP + g.mt * 256 + wc * 64 + n * 16 + fr;
#pragma unroll
            for (int q1 = 0; q1 < 2; ++q1) {
                u32x2 ab[2];
#pragma unroll
                for (int j = 0; j < 2; ++j) {
                    const int mq = 2 * q1 + j;
                    float h[4];
#pragma unroll
                    for (int r = 0; r < 4; ++r) h[r] = siluf_(acc[mq][n][r]) * acc[mq + 4][n][r];
                    ab[j].x = cvt_pk_bf16(h[0], h[1]); ab[j].y = cvt_pk_bf16(h[2], h[3]);
                }
                *(u32x4*)(HID + hid_off(row, g.nt * 128 + wr * 64 + 32 * q1 + swz8(fq))) = pair_swap16(ab[0], ab[1]);
            }
        }
    } else {
        bf16_t* OUTB = WSP(bf16_t, WS_OUTB);
        const float* GATE = WSP(float, WS_GATE);
#pragma unroll
        for (int m = 0; m < 8; ++m) {
            const int sl = g.mt * 256 + wr * 128 + m * 16 + fr;
            const float gt = GATE[(size_t)g.be * CAP + sl];
            const size_t row = (size_t)g.be * CAP + sl;
            bf16_t* orow = OUTB + row * D + g.nt * 256 + wc * 64 + swz8(fq);
#pragma unroll
            for (int n1 = 0; n1 < 2; ++n1) {
                u32x2 a, b;
                a.x = cvt_pk_bf16(acc[m][2 * n1][0] * gt, acc[m][2 * n1][1] * gt); a.y = cvt_pk_bf16(acc[m][2 * n1][2] * gt, acc[m][2 * n1][3] * gt);
                b.x = cvt_pk_bf16(acc[m][2 * n1 + 1][0] * gt, acc[m][2 * n1 + 1][1] * gt); b.y = cvt_pk_bf16(acc[m][2 * n1 + 1][2] * gt, acc[m][2 * n1 + 1][3] * gt);
                *(u32x4*)(orow + 32 * n1) = pair_swap16(a, b);
            }
        }
    }
}

__device__ __forceinline__ void phase_gemm(const Params& p, int mode, int l, unsigned char* smem) {
    const int bid = blockIdx.x, nb = gridDim.x;
    GemmJob g; g.mode = mode; g.l = l; g.be = 0; g.e = 0;
    if (mode == G_PROJ) {
        g.A = WSP(bf16_t, WS_HB); g.B = wt_in(p, l);
        if ((nb & 7) == 0) {
            const int xcd = bid & 7, j = bid >> 3, nj = nb >> 3;
            for (int q = j; q < 16 * 14; q += nj) { g.mt = (q / 14) * 8 + xcd; g.nt = q % 14; gemm_tile(p, g, smem); }
        } else
        for (int t = bid; t < 128 * 14; t += nb) { g.mt = t / 14; g.nt = t % 14; gemm_tile(p, g, smem); }
    } else if (mode == G_OUT) {
        g.A = WSP(bf16_t, WS_HB); g.B = wt_out(p, l);
        if ((nb & 7) == 0) {
            const int xcd = bid & 7, j = bid >> 3, nj = nb >> 3;
            for (int q = j; q < 16 * 4; q += nj) { g.mt = (q / 4) * 8 + xcd; g.nt = q % 4; gemm_tile(p, g, smem); }
        } else
        for (int t = bid; t < 128 * 4; t += nb) { g.mt = t / 4; g.nt = t % 4; gemm_tile(p, g, smem); }
    } else if (mode == G_MOE1) {
        for (int t = bid; t < 16 * 8 * 16; t += nb) {
            const int e = t >> 7, nt = (t >> 4) & 7, bm = t & 15, b = bm >> 1, mt = bm & 1;
            g.e = e; g.be = b * 16 + e; g.mt = mt; g.nt = nt;
            g.A = WSP(bf16_t, WS_HB); g.B = WSP(bf16_t, WS_WTEXP) + (size_t)(e * 3) * D * D;
            gemm_tile(p, g, smem);
        }
    } else {
        for (int t = bid; t < 16 * 4 * 16; t += nb) {
            const int e = t >> 6, nt = (t >> 4) & 3, bm = t & 15, b = bm >> 1, mt = bm & 1;
            g.e = e; g.be = b * 16 + e; g.mt = mt; g.nt = nt;
            g.A = WSP(bf16_t, WS_HID); g.B = WSP(bf16_t, WS_WTEXP) + (size_t)(e * 3 + 2) * D * D;
            gemm_tile(p, g, smem);
        }
    }
}

constexpr int P72 = 144;
constexpr int P40 = 80;
__device__ __forceinline__ void lds_st16(unsigned char* base, int off, float v) { *(bf16_t*)(base + off) = f2bf(v); }

__device__ __forceinline__ void ret_chain(const Params& p, int l, int b, int h, int dir, unsigned char* smem) {
    int tid_ = (threadIdx.x & 255); asm volatile("" : "+v"(tid_)); const int tid = tid_, lane = tid & 63, wave = tid >> 6, wr = wave >> 1, wc = wave & 1, fr = lane & 15, fq = lane >> 4;
    unsigned char* Qs = smem; unsigned char* Ks = smem + 9216; unsigned char* KtZ = smem + 18432; unsigned char* Vt = smem + 27648;
    unsigned char* Ps = smem + 36864; unsigned char* St = smem + 46080; float* stats = (float*)(smem + 55296);
    const bf16_t* PROJ = WSP(bf16_t, WS_PROJ);
    const f32x2* ROT = WSP(f32x2, WS_ROT);
    bf16_t* YF = dir ? WSP(bf16_t, WS_HB) : yt_buf(p, 0); constexpr int YCB = 0;
    const int li = tid >> 2, lp = tid & 3;
    {
        __syncthreads();
        const float lg2 = p.in[5][(l * 2 + dir) * 4 + h] * 1.4426950408889634f;
        const float cdec = exp2f(lg2 * 64.f);
        f32x4 sacc[2][2];
#pragma unroll
        for (int m = 0; m < 2; ++m)
#pragma unroll
            for (int n = 0; n < 2; ++n) sacc[m][n] = (f32x4){0.f, 0.f, 0.f, 0.f};
        for (int i = tid; i < 9216 / 4; i += NTHREADS) ((unsigned*)St)[i] = 0u;
        u32x4 q1, q2, k1, k2, v1, v2;
#define RET_LOAD(c) do { const int s_ = (c) * 64 + li; const size_t tok_ = (size_t)b * SEQ + (dir ? (SEQ - 1 - s_) : s_); const bf16_t* pr_ = PROJ + tok_ * PINC + h * 64 + 8 * lp; \
        q1 = *(const u32x4*)(pr_ + C_RQ); q2 = *(const u32x4*)(pr_ + C_RQ + 32); k1 = *(const u32x4*)(pr_ + C_RK); k2 = *(const u32x4*)(pr_ + C_RK + 32); \
        v1 = *(const u32x4*)(pr_ + C_RV); v2 = *(const u32x4*)(pr_ + C_RV + 32); } while (0)
        RET_LOAD(0);
#pragma unroll 1
        for (int c = 0; c < 64; ++c) {
            __syncthreads();
            {
                *(u32x4*)(Qs + li * P72 + 16 * lp) = q1; *(u32x4*)(Qs + li * P72 + 64 + 16 * lp) = q2;
                *(u32x4*)(Ks + li * P72 + 16 * lp) = k1; *(u32x4*)(Ks + li * P72 + 64 + 16 * lp) = k2;
                const float zeta = exp2f(lg2 * (float)(63 - li));
                float ka[8], kb[8];
                unpack8(k1, ka); unpack8(k2, kb);
#pragma unroll
                for (int j = 0; j < 8; ++j) { lds_st16(KtZ, (8 * lp + j) * P72 + li * 2, ka[j] * zeta); lds_st16(KtZ, (32 + 8 * lp + j) * P72 + li * 2, kb[j] * zeta); }
                const unsigned vw[8] = {v1.x, v1.y, v1.z, v1.w, v2.x, v2.y, v2.z, v2.w};
#pragma unroll
                for (int j = 0; j < 4; ++j) {
                    *(bf16_t*)(Vt + (8 * lp + 2 * j) * P72 + li * 2) = (bf16_t)(vw[j] & 0xffffu); *(bf16_t*)(Vt + (8 * lp + 2 * j + 1) * P72 + li * 2) = (bf16_t)(vw[j] >> 16);
                    *(bf16_t*)(Vt + (32 + 8 * lp + 2 * j) * P72 + li * 2) = (bf16_t)(vw[4 + j] & 0xffffu); *(bf16_t*)(Vt + (32 + 8 * lp + 2 * j + 1) * P72 + li * 2) = (bf16_t)(vw[4 + j] >> 16);
                }
            }
            __syncthreads();
            f32x4 yc[2][2];
            {
                f32x4 sc[2][2];
#pragma unroll
                for (int m = 0; m < 2; ++m)
#pragma unroll
                    for (int n = 0; n < 2; ++n) { sc[m][n] = (f32x4){0.f, 0.f, 0.f, 0.f}; yc[m][n] = (f32x4){0.f, 0.f, 0.f, 0.f}; }
#pragma unroll
                for (int kk = 0; kk < 2; ++kk) {
                    bf16x8 qf[2], kf[2], sf[2];
#pragma unroll
                    for (int m = 0; m < 2; ++m) qf[m] = LDS_FRAG(Qs, (32 * wr + 16 * m + fr) * P72 + (32 * kk + 8 * fq) * 2);
#pragma unroll
                    for (int n = 0; n < 2; ++n) { kf[n] = LDS_FRAG(Ks, (32 * wc + 16 * n + fr) * P72 + (32 * kk + 8 * fq) * 2); sf[n] = LDS_FRAG(St, (32 * wc + 16 * n + fr) * P72 + (32 * kk + 8 * fq) * 2); }
#pragma unroll
                    for (int m = 0; m < 2; ++m)
#pragma unroll
                        for (int n = 0; n < 2; ++n) { sc[m][n] = MFMA16(kf[n], qf[m], sc[m][n]); yc[m][n] = MFMA16(sf[n], qf[m], yc[m][n]); }
                    __builtin_amdgcn_sched_barrier(0);
                }
#pragma unroll
                for (int m = 0; m < 2; ++m)
#pragma unroll
                    for (int n = 0; n < 2; ++n) {
                        const int i = 32 * wr + 16 * m + fr, j0 = 32 * wc + 16 * n + 4 * fq;
                        float pv[4];
#pragma unroll
                        for (int r = 0; r < 4; ++r) { const int dlt = i - (j0 + r); pv[r] = (dlt >= 0) ? sc[m][n][r] * exp2f(lg2 * (float)dlt) : 0.f; }
                        u32x2 o; o.x = cvt_pk_bf16(pv[0], pv[1]); o.y = cvt_pk_bf16(pv[2], pv[3]);
                        *(u32x2*)(Ps + i * P72 + j0 * 2) = o;
                    }
            }
            __syncthreads();
            if (c + 1 < 64) RET_LOAD(c + 1);
            f32x4 y[2][2];
#pragma unroll
            for (int m = 0; m < 2; ++m)
#pragma unroll
                for (int n = 0; n < 2; ++n) { y[m][n] = (f32x4){0.f, 0.f, 0.f, 0.f}; sacc[m][n] = sacc[m][n] * cdec; }
#pragma unroll
            for (int kk = 0; kk < 2; ++kk) {
                bf16x8 pf[2], vf[2], zf[2];
#pragma unroll
                for (int m = 0; m < 2; ++m) { pf[m] = LDS_FRAG(Ps, (32 * wr + 16 * m + fr) * P72 + (32 * kk + 8 * fq) * 2); zf[m] = LDS_FRAG(KtZ, (32 * wr + 16 * m + fr) * P72 + (32 * kk + 8 * fq) * 2); }
#pragma unroll
                for (int n = 0; n < 2; ++n) vf[n] = LDS_FRAG(Vt, (32 * wc + 16 * n + fr) * P72 + (32 * kk + 8 * fq) * 2);
#pragma unroll
                for (int m = 0; m < 2; ++m)
#pragma unroll
                    for (int n = 0; n < 2; ++n) { y[m][n] = MFMA16(vf[n], pf[m], y[m][n]); sacc[m][n] = MFMA16(zf[m], vf[n], sacc[m][n]); }
                __builtin_amdgcn_sched_barrier(0);
            }
#pragma unroll
            for (int m = 0; m < 2; ++m)
#pragma unroll
                for (int n = 0; n < 2; ++n) {
                    u32x2 o; o.x = cvt_pk_bf16(sacc[m][n][0], sacc[m][n][1]); o.y = cvt_pk_bf16(sacc[m][n][2], sacc[m][n][3]);
                    *(u32x2*)(St + (32 * wc + 16 * n + fr) * P72 + (32 * wr + 16 * m + 4 * fq) * 2) = o;
                }
            {
#pragma unroll
                for (int m = 0; m < 2; ++m) {
                    const int i = 32 * wr + 16 * m + fr; const float xi = exp2f(lg2 * (float)(i + 1));
                    const int s = c * 64 + i; const size_t tok = (size_t)b * SEQ + (dir ? (SEQ - 1 - s) : s);
#pragma unroll
                    for (int n = 0; n < 2; ++n) {
                        const f32x4 yy = y[m][n] + yc[m][n] * xi;
                        u32x2 o; o.x = cvt_pk_bf16(yy[0], yy[1]); o.y = cvt_pk_bf16(yy[2], yy[3]);
                        { const int yc_ = h * 64 + 32 * wc + 16 * n + 4 * fq; *(u32x2*)(YF + (dir ? hb_off(tok, YCB + yc_) : tok * 256 + yc_)) = o; }
                    }
                }
            }
        }
#undef RET_LOAD
        __syncthreads();
    }
}

__device__ __forceinline__ void gla_chain(const Params& p, int l, int b, int h, int dir, unsigned char* smem) {
    int tid_ = (threadIdx.x & 255); asm volatile("" : "+v"(tid_)); const int tid = tid_, lane = tid & 63, wave = tid >> 6, wr = wave >> 1, wc = wave & 1, fr = lane & 15, fq = lane >> 4;
    unsigned char* Qd = smem; unsigned char* Kd = smem + 5120; unsigned char* KeT = smem + 10240; unsigned char* Vt = smem + 14848;
    unsigned char* Ps = smem + 24064; unsigned char* St = smem + 33280;
    float* bcum = (float*)(smem + 38400);
    float* gsum = (float*)(smem + 46592);
    float* xas = (float*)(smem + 47616);
    float* stats = (float*)(smem + 51712);
    const bf16_t* PROJ = WSP(bf16_t, WS_PROJ);
    bf16_t* YF = dir ? WSP(bf16_t, WS_HB) : yt_buf(p, 1); constexpr int YCB = 768;
    const int li = tid >> 2, lc = tid & 3;
    const int ck = tid & 31, cg = tid >> 5;
    {
        __syncthreads();
        float au[16];
#pragma unroll
        for (int r = 0; r < 16; ++r) au[r] = p.in[24][((size_t)(l * 2 + dir) * 16 + r) * 128 + h * 32 + ck];
        const float ab = p.in[25][(l * 2 + dir) * 128 + h * 32 + ck];
        f32x4 sacc[2];
        sacc[0] = (f32x4){0.f, 0.f, 0.f, 0.f}; sacc[1] = (f32x4){0.f, 0.f, 0.f, 0.f};
        for (int i = tid; i < 5120 / 4; i += NTHREADS) ((unsigned*)St)[i] = 0u;
#pragma unroll 1
        for (int c = 0; c < 64; ++c) {
            __syncthreads();
            if (tid < 128) {
                const int i = tid >> 1, hf = tid & 1; const int s = c * 64 + i; const size_t tok = (size_t)b * SEQ + (dir ? (SEQ - 1 - s) : s);
                const u32x4 xv = *(const u32x4*)(PROJ + tok * PINC + C_GXA + 8 * hf);
                float f[8]; unpack8(xv, f);
#pragma unroll
                for (int j = 0; j < 8; ++j) xas[i * 16 + 8 * hf + j] = f[j];
            }
            const int s3 = c * 64 + li; const size_t tok3 = (size_t)b * SEQ + (dir ? (SEQ - 1 - s3) : s3);
            const u32x4 qv = *(const u32x4*)(PROJ + tok3 * PINC + C_GQ + h * 32 + 8 * lc);
            const u32x4 kv = *(const u32x4*)(PROJ + tok3 * PINC + C_GK + h * 32 + 8 * lc);
            const u32x4 va = *(const u32x4*)(PROJ + tok3 * PINC + C_GV + h * 64 + 16 * lc);
            const u32x4 vb = *(const u32x4*)(PROJ + tok3 * PINC + C_GV + h * 64 + 16 * lc + 8);
            __syncthreads();
            float loc[8];
            {
                float run = 0.f;
#pragma unroll
                for (int ii = 0; ii < 8; ++ii) {
                    const int i = 8 * cg + ii; float z = ab;
#pragma unroll
                    for (int r = 0; r < 16; ++r) z += xas[i * 16 + r] * au[r];
                    const float la = -softplusf_(-z) * (1.f / 16.f);
                    run += la; loc[ii] = run;
                }
                gsum[cg * 32 + ck] = run;
            }
            __syncthreads();
            {
                float off = 0.f;
#pragma unroll
                for (int g2 = 0; g2 < 8; ++g2) off += (g2 < cg) ? gsum[g2 * 32 + ck] : 0.f;
#pragma unroll
                for (int ii = 0; ii < 8; ++ii) bcum[(8 * cg + ii) * 32 + ck] = loc[ii] + off;
            }
            __syncthreads();
            {
                float qf[8], kf[8], v16[16], qd[8], kd[8];
                unpack8(qv, qf); unpack8(kv, kf); unpack8(va, v16); unpack8(vb, v16 + 8);
#pragma unroll
                for (int j = 0; j < 8; ++j) {
                    const float bc = bcum[li * 32 + 8 * lc + j], bl = bcum[63 * 32 + 8 * lc + j];
                    qd[j] = qf[j] * __expf(bc) * 0.17677669529663687f; kd[j] = kf[j] * __expf(-bc);
                    lds_st16(KeT, (8 * lc + j) * P72 + li * 2, kf[j] * __expf(bl - bc));
                }
                *(u32x4*)(Qd + li * P40 + 16 * lc) = pack8(qd); *(u32x4*)(Kd + li * P40 + 16 * lc) = pack8(kd);
#pragma unroll
                for (int j = 0; j < 16; ++j) lds_st16(Vt, (16 * lc + j) * P72 + li * 2, v16[j]);
            }
            __syncthreads();
            f32x4 yc[2][2];
            {
                f32x4 sc[2][2];
                bf16x8 qfr[2], kfr[2], sfr[2];
#pragma unroll
                for (int m = 0; m < 2; ++m) qfr[m] = LDS_FRAG(Qd, (32 * wr + 16 * m + fr) * P40 + 16 * fq);
#pragma unroll
                for (int n = 0; n < 2; ++n) { kfr[n] = LDS_FRAG(Kd, (32 * wc + 16 * n + fr) * P40 + 16 * fq); sfr[n] = LDS_FRAG(St, (32 * wc + 16 * n + fr) * P40 + 16 * fq); }
#pragma unroll
                for (int m = 0; m < 2; ++m)
#pragma unroll
                    for (int n = 0; n < 2; ++n) {
                        sc[m][n] = MFMA16(kfr[n], qfr[m], ((f32x4){0.f, 0.f, 0.f, 0.f})); yc[m][n] = MFMA16(sfr[n], qfr[m], ((f32x4){0.f, 0.f, 0.f, 0.f}));
                        const int i = 32 * wr + 16 * m + fr, j0 = 32 * wc + 16 * n + 4 * fq;
                        float pv[4];
#pragma unroll
                        for (int r = 0; r < 4; ++r) pv[r] = (i >= j0 + r) ? sc[m][n][r] : 0.f;
                        u32x2 o; o.x = cvt_pk_bf16(pv[0], pv[1]); o.y = cvt_pk_bf16(pv[2], pv[3]);
                        *(u32x2*)(Ps + i * P72 + j0 * 2) = o;
                    }
            }
            __syncthreads();
            f32x4 y[2][2];
#pragma unroll
            for (int m = 0; m < 2; ++m)
#pragma unroll
                for (int n = 0; n < 2; ++n) y[m][n] = yc[m][n];
            {
                float dk[4];
#pragma unroll
                for (int r = 0; r < 4; ++r) dk[r] = __expf(bcum[63 * 32 + 16 * wr + 4 * fq + r]);
#pragma unroll
                for (int n = 0; n < 2; ++n)
#pragma unroll
                    for (int r = 0; r < 4; ++r) sacc[n][r] *= dk[r];
            }
#pragma unroll
            for (int kk = 0; kk < 2; ++kk) {
                bf16x8 pf[2], vf[2];
#pragma unroll
                for (int m = 0; m < 2; ++m) pf[m] = LDS_FRAG(Ps, (32 * wr + 16 * m + fr) * P72 + (32 * kk + 8 * fq) * 2);
#pragma unroll
                for (int n = 0; n < 2; ++n) vf[n] = LDS_FRAG(Vt, (32 * wc + 16 * n + fr) * P72 + (32 * kk + 8 * fq) * 2);
                const bf16x8 kef = LDS_FRAG(KeT, (16 * wr + fr) * P72 + (32 * kk + 8 * fq) * 2);
#pragma unroll
                for (int m = 0; m < 2; ++m)
#pragma unroll
                    for (int n = 0; n < 2; ++n) y[m][n] = MFMA16(vf[n], pf[m], y[m][n]);
#pragma unroll
                for (int n = 0; n < 2; ++n) sacc[n] = MFMA16(kef, vf[n], sacc[n]);
            }
#pragma unroll
            for (int n = 0; n < 2; ++n) {
                u32x2 o; o.x = cvt_pk_bf16(sacc[n][0], sacc[n][1]); o.y = cvt_pk_bf16(sacc[n][2], sacc[n][3]);
                *(u32x2*)(St + (32 * wc + 16 * n + fr) * P40 + (16 * wr + 4 * fq) * 2) = o;
            }
            {
#pragma unroll
                for (int m = 0; m < 2; ++m) {
                    const int i = 32 * wr + 16 * m + fr; const int s = c * 64 + i; const size_t tok = (size_t)b * SEQ + (dir ? (SEQ - 1 - s) : s);
#pragma unroll
                    for (int n = 0; n < 2; ++n) {
                        u32x2 o; o.x = cvt_pk_bf16(y[m][n][0], y[m][n][1]); o.y = cvt_pk_bf16(y[m][n][2], y[m][n][3]);
                        { const int yc_ = h * 64 + 32 * wc + 16 * n + 4 * fq; *(u32x2*)(YF + (dir ? hb_off(tok, YCB + yc_) : tok * 256 + yc_)) = o; }
                    }
                }
            }
        }
        __syncthreads();
    }
}

__device__ __forceinline__ void lru_chain(const Params& p, int l, int b, int hd, int dir, unsigned char* smem) {
    int tid_ = (threadIdx.x & 255); asm volatile("" : "+v"(tid_)); const int tid = tid_, lane = tid & 63, wave = tid >> 6, wr = wave >> 1, wc = wave & 1, fr = lane & 15, fq = lane >> 4;
    unsigned char* W0t = smem; unsigned char* W1t = smem + 9216; unsigned char* Xc = smem + 18432;
    float* Aa = (float*)(smem + 27648); float* Bx = (float*)(smem + 44032);
    const bf16_t* PROJ = WSP(bf16_t, WS_PROJ);
    bf16_t* YF = dir ? WSP(bf16_t, WS_HB) : yt_buf(p, 2); constexpr int YCB = 512;
    const bf16_t* sw = wt_small(p, l) + SW_LRU;
    const int li = tid >> 2, lc = tid & 3;
    float* CW = (float*)(smem + 60416);
    __syncthreads();
    for (int i = tid; i < 320; i += NTHREADS) CW[i] = (i < 256) ? p.in[19][(size_t)l * 1024 + (i >> 6) * 256 + hd * 64 + (i & 63)] : p.in[20][(size_t)l * 256 + hd * 64 + (i & 63)];
    const float* cw = CW + 16 * lc;
    {
        __syncthreads();
        for (int i = tid; i < 2 * 64 * 8; i += NTHREADS) {
            const int g = i >> 9, r = (i >> 3) & 63, ch = i & 7;
            const u32x4 v = *(const u32x4*)(sw + ((size_t)((dir * 2 + g) * 4 + hd)) * 4096 + r * 64 + ch * 8);
            *(u32x4*)((g ? W1t : W0t) + r * P72 + ch * 16) = v;
        }
        float sp8[2][4], b0[2][4], b1[2][4];
#pragma unroll
        for (int n = 0; n < 2; ++n)
#pragma unroll
            for (int r = 0; r < 4; ++r) {
                const int e = hd * 64 + 32 * wc + 16 * n + 4 * fq + r;
                sp8[n][r] = 8.f * softplusf_(-p.in[23][(l * 2 + dir) * 256 + e]);
                b0[n][r] = p.in[22][((l * 2 + dir) * 2 + 0) * 256 + e]; b1[n][r] = p.in[22][((l * 2 + dir) * 2 + 1) * 256 + e];
            }
        float hcar = 0.f;
        u32x4 lxa[4], lxb[4];
#define LRU_LOAD(c) do { const int s_ = (c) * 64 + li; const int t_ = dir ? (SEQ - 1 - s_) : s_; \
            _Pragma("unroll") for (int tap = 0; tap < 4; ++tap) { const int tt = t_ + tap - 2; lxa[tap] = (u32x4){0u, 0u, 0u, 0u}; lxb[tap] = (u32x4){0u, 0u, 0u, 0u}; \
                if (tt >= 0 && tt < SEQ) { const bf16_t* src_ = PROJ + ((size_t)b * SEQ + tt) * PINC + C_LX + hd * 64 + 16 * lc; lxa[tap] = *(const u32x4*)src_; lxb[tap] = *(const u32x4*)(src_ + 8); } } } while (0)
        LRU_LOAD(0);
#pragma unroll 1
        for (int c = 0; c < 64; ++c) {
            {
                float xc[16];
#pragma unroll
                for (int j = 0; j < 16; ++j) xc[j] = cw[256 + j];
#pragma unroll
                for (int tap = 0; tap < 4; ++tap) {
                    float f[16]; unpack8(lxa[tap], f); unpack8(lxb[tap], f + 8);
#pragma unroll
                    for (int j = 0; j < 16; ++j) xc[j] += f[j] * cw[tap * 64 + j];
                }
                *(u32x4*)(Xc + li * P72 + 32 * lc) = pack8(xc); *(u32x4*)(Xc + li * P72 + 32 * lc + 16) = pack8(xc + 8);
            }
            __syncthreads();
            if (c + 1 < 64) LRU_LOAD(c + 1);
            {
                f32x4 g0[2][2], g1[2][2];
#pragma unroll
                for (int m = 0; m < 2; ++m)
#pragma unroll
                    for (int n = 0; n < 2; ++n) { g0[m][n] = (f32x4){0.f, 0.f, 0.f, 0.f}; g1[m][n] = (f32x4){0.f, 0.f, 0.f, 0.f}; }
#pragma unroll
                for (int kk = 0; kk < 2; ++kk) {
                    bf16x8 xf[2], w0f[2], w1f[2];
#pragma unroll
                    for (int m = 0; m < 2; ++m) xf[m] = LDS_FRAG(Xc, (32 * wr + 16 * m + fr) * P72 + (32 * kk + 8 * fq) * 2);
#pragma unroll
                    for (int n = 0; n < 2; ++n) { w0f[n] = LDS_FRAG(W0t, (32 * wc + 16 * n + fr) * P72 + (32 * kk + 8 * fq) * 2); w1f[n] = LDS_FRAG(W1t, (32 * wc + 16 * n + fr) * P72 + (32 * kk + 8 * fq) * 2); }
#pragma unroll
                    for (int m = 0; m < 2; ++m)
#pragma unroll
                        for (int n = 0; n < 2; ++n) { g0[m][n] = MFMA16(w0f[n], xf[m], g0[m][n]); g1[m][n] = MFMA16(w1f[n], xf[m], g1[m][n]); }
                }
#pragma unroll
                for (int m = 0; m < 2; ++m)
#pragma unroll
                    for (int n = 0; n < 2; ++n) {
                        const int i = 32 * wr + 16 * m + fr, e0 = 32 * wc + 16 * n + 4 * fq;
                        const u32x2 xv = *(const u32x2*)(Xc + i * P72 + e0 * 2);
                        const float x4[4] = {bf_lo(xv.x), bf_hi(xv.x), bf_lo(xv.y), bf_hi(xv.y)};
                        f32x4 av, bv;
#pragma unroll
                        for (int r = 0; r < 4; ++r) {
                            const float la = -sp8[n][r] * sigmoidf_(g0[m][n][r] + b0[n][r]);
                            av[r] = __expf(la);
                            const float x2 = 2.f * la;
                            const float em = (x2 > -0.25f) ? -x2 * (1.f + x2 * (0.5f + x2 * (0.16666667f + x2 * (0.041666668f + x2 * (0.0083333338f + x2 * 0.0013888889f))))) : 1.f - __expf(x2);
                            bv[r] = __builtin_amdgcn_sqrtf(em) * sigmoidf_(g1[m][n][r] + b1[n][r]) * x4[r];
                        }
                        *(f32x4*)(Aa + i * 64 + e0) = av; *(f32x4*)(Bx + i * 64 + e0) = bv;
                    }
            }
            __syncthreads();
            if (wave == 0) {
#pragma unroll 8
                for (int i = 0; i < 64; ++i) { hcar = Aa[i * 64 + lane] * hcar + Bx[i * 64 + lane]; Bx[i * 64 + lane] = hcar; }
            }
            __syncthreads();
            {
                const int s = c * 64 + li; const int t = dir ? (SEQ - 1 - s) : s; const size_t tok = (size_t)b * SEQ + t;
                float hv[16];
#pragma unroll
                for (int j = 0; j < 4; ++j) { const f32x4 v = *(const f32x4*)(Bx + li * 64 + 16 * lc + 4 * j); hv[4 * j] = v.x; hv[4 * j + 1] = v.y; hv[4 * j + 2] = v.z; hv[4 * j + 3] = v.w; }
                bf16_t* yo_ = YF + (dir ? hb_off(tok, YCB + hd * 64 + 16 * lc) : tok * 256 + hd * 64 + 16 * lc);
                *(u32x4*)yo_ = pack8(hv); *(u32x4*)(yo_ + 8) = pack8(hv + 8);
            }
        }
#undef LRU_LOAD
    }
    __syncthreads();
}

__device__ __forceinline__ void rwkv_prepass_item(const Params& p, int l, int item, unsigned char* smem) {
    int tid_ = (threadIdx.x & 255); asm volatile("" : "+v"(tid_)); const int tid = tid_, lane = tid & 63, wave = tid >> 6, fr = lane & 15, fq = lane >> 4;
    constexpr int PA = 528;
    unsigned char* XW = smem; unsigned char* XA = smem + 9216; unsigned char* AL = smem + 18432;
    const bf16_t* PROJ = WSP(bf16_t, WS_PROJ);
    const bf16_t* sw = wt_small(p, l);
    const int dir = item & 1; const size_t tok0 = (size_t)(item >> 1) * 64; const int t0 = (int)(tok0 & (SEQ - 1));
    bf16_t* WA = WSP(bf16_t, WS_WA) + (size_t)dir * NTOK * 512;
    float* SC = WSP(float, WS_SC) + (size_t)dir * NTOK * 16;
    const int li = tid >> 2, lc = tid & 3;
    const int t = t0 + li; const size_t tok = tok0 + li;
    const bool hp = dir ? (t < SEQ - 1) : (t > 0);
    const bf16_t* pc = PROJ + tok * PINC; const bf16_t* pp = dir ? pc + PINC : pc - PINC;
    __syncthreads();
    {
        const u32x4 z = {0u, 0u, 0u, 0u};
#pragma unroll
        for (int hf = 0; hf < 2; ++hf) {
            const u32x4 wc_ = *(const u32x4*)(pc + C_WXW + 16 * lc + 8 * hf), wp_ = hp ? *(const u32x4*)(pp + C_WXW + 16 * lc + 8 * hf) : z;
            const u32x4 ac_ = *(const u32x4*)(pc + C_WXA + 16 * lc + 8 * hf), ap_ = hp ? *(const u32x4*)(pp + C_WXA + 16 * lc + 8 * hf) : z;
            float a[8], bq[8], o[8];
            unpack8(wc_, a); unpack8(wp_, bq);
#pragma unroll
            for (int j = 0; j < 8; ++j) o[j] = tanhf_(a[j] + p.in[8][l * 64 + 16 * lc + 8 * hf + j] * (bq[j] - a[j]));
            *(u32x4*)(XW + li * P72 + 32 * lc + 16 * hf) = pack8(o);
            unpack8(ac_, a); unpack8(ap_, bq);
#pragma unroll
            for (int j = 0; j < 8; ++j) o[j] = a[j] + p.in[9][l * 64 + 16 * lc + 8 * hf + j] * (bq[j] - a[j]);
            *(u32x4*)(XA + li * P72 + 32 * lc + 16 * hf) = pack8(o);
        }
    }
    __syncthreads();
#pragma unroll
    for (int which = 0; which < 2; ++which) {
        f32x4 acc[4][4];
#pragma unroll
        for (int m = 0; m < 4; ++m)
#pragma unroll
            for (int n = 0; n < 4; ++n) acc[m][n] = (f32x4){0.f, 0.f, 0.f, 0.f};
        const unsigned char* XS = which ? XA : XW;
        const bf16_t* wsrc = sw + (which ? SW_AUP : SW_WUP) + dir * 16384;
#pragma unroll
        for (int kk = 0; kk < 2; ++kk) {
            bf16x8 xf[4];
#pragma unroll
            for (int m = 0; m < 4; ++m) xf[m] = LDS_FRAG(XS, (16 * m + fr) * P72 + (32 * kk + 8 * fq) * 2);
#pragma unroll
            for (int n = 0; n < 4; ++n) {
                const bf16x8 bw = *(const bf16x8*)(wsrc + (64 * wave + 16 * n + fr) * 64 + 32 * kk + 8 * fq);
#pragma unroll
                for (int m = 0; m < 4; ++m) acc[m][n] = MFMA16(bw, xf[m], acc[m][n]);
            }
        }
#pragma unroll
        for (int n1 = 0; n1 < 2; ++n1) {
            const f32x4 c0a = *(const f32x4*)(p.in[which ? 12 : 10] + (l * 2 + dir) * 256 + 64 * wave + 32 * n1 + 4 * fq);
            const f32x4 c0b = *(const f32x4*)(p.in[which ? 12 : 10] + (l * 2 + dir) * 256 + 64 * wave + 32 * n1 + 16 + 4 * fq);
            const int colw = 64 * wave + 32 * n1 + swz8(fq);
#pragma unroll
            for (int m = 0; m < 4; ++m) {
                float oa[4], ob[4];
#pragma unroll
                for (int r = 0; r < 4; ++r) {
                    const float sa = sigmoidf_(c0a[r] + acc[m][2 * n1][r]), sb = sigmoidf_(c0b[r] + acc[m][2 * n1 + 1][r]);
                    oa[r] = which ? sa : -0.8750387749f * sa; ob[r] = which ? sb : -0.8750387749f * sb;
                }
                u32x2 a, b; a.x = cvt_pk_bf16(oa[0], oa[1]); a.y = cvt_pk_bf16(oa[2], oa[3]); b.x = cvt_pk_bf16(ob[0], ob[1]); b.y = cvt_pk_bf16(ob[2], ob[3]);
                const u32x4 o = pair_swap16(a, b);
                *(u32x4*)(WA + (tok0 + 16 * m + fr) * 512 + which * 256 + colw) = o;
                if (which) *(u32x4*)(AL + (16 * m + fr) * PA + colw * 2) = o;
            }
        }
        __builtin_amdgcn_sched_barrier(0);
    }
    __syncthreads();
    {
        const int col = (tid & 31) * 8;
        float muk[8], mur[8], kkq[8], kaq[8], bnq[8];
        {
            const f32x4 a0 = *(const f32x4*)(p.in[7] + (size_t)l * 768 + 256 + col), a1 = *(const f32x4*)(p.in[7] + (size_t)l * 768 + 256 + col + 4);
            const f32x4 b0 = *(const f32x4*)(p.in[7] + (size_t)l * 768 + col), b1 = *(const f32x4*)(p.in[7] + (size_t)l * 768 + col + 4);
            const f32x4 c0 = *(const f32x4*)(p.in[15] + l * 256 + col), c1 = *(const f32x4*)(p.in[15] + l * 256 + col + 4);
            const f32x4 d0 = *(const f32x4*)(p.in[16] + l * 256 + col), d1 = *(const f32x4*)(p.in[16] + l * 256 + col + 4);
            const f32x4 e0 = *(const f32x4*)(p.in[17] + l * 256 + col), e1 = *(const f32x4*)(p.in[17] + l * 256 + col + 4);
#pragma unroll
            for (int j = 0; j < 4; ++j) { muk[j] = a0[j]; muk[4 + j] = a1[j]; mur[j] = b0[j]; mur[4 + j] = b1[j]; kkq[j] = c0[j]; kkq[4 + j] = c1[j]; kaq[j] = d0[j]; kaq[4 + j] = d1[j]; bnq[j] = e0[j]; bnq[4 + j] = e1[j]; }
        }
        const u32x4 z = {0u, 0u, 0u, 0u};
#pragma unroll 2
        for (int rr = 0; rr < 8; ++rr) {
            const int lt = rr * 8 + (tid >> 5);
            const int tt = t0 + lt; const size_t tk = tok0 + lt;
            const bool hq = dir ? (tt < SEQ - 1) : (tt > 0);
            const bf16_t* qc = PROJ + tk * PINC; const bf16_t* qp = dir ? qc + PINC : qc - PINC;
            const u32x4 kc_ = *(const u32x4*)(qc + C_WK + col), kp_ = hq ? *(const u32x4*)(qp + C_WK + col) : z;
            const u32x4 rc_ = *(const u32x4*)(qc + C_WR + col), rp_ = hq ? *(const u32x4*)(qp + C_WR + col) : z;
            const u32x4 al_ = *(const u32x4*)(AL + lt * PA + col * 2);
            float kc[8], kp[8], rc[8], rp[8], av[8];
            unpack8(kc_, kc); unpack8(kp_, kp); unpack8(rc_, rc); unpack8(rp_, rp); unpack8(al_, av);
            float ss = 0.f, u1 = 0.f, c2 = 0.f, bon = 0.f;
#pragma unroll
            for (int j = 0; j < 8; ++j) {
                const float ks = kc[j] + muk[j] * (kp[j] - kc[j]);
                const float rs = rc[j] + mur[j] * (rp[j] - rc[j]);
                const float kk = ks * kkq[j];
                const float km = ks * (1.f + (av[j] - 1.f) * kaq[j]);
                ss += kk * kk; u1 += kk * av[j] * rs; c2 += km * rs; bon += rs * km * bnq[j];
            }
            ss += dpp_xor1(ss); u1 += dpp_xor1(u1); c2 += dpp_xor1(c2); bon += dpp_xor1(bon);
            ss += dpp_xor2(ss); u1 += dpp_xor2(u1); c2 += dpp_xor2(c2); bon += dpp_xor2(bon);
            ss += dpp_hmirror(ss); u1 += dpp_hmirror(u1); c2 += dpp_hmirror(c2); bon += dpp_hmirror(bon);
            const float inv = 1.f / fmaxf(sqrtf(ss), 1e-12f);
            if ((tid & 7) == 0) *(f32x4*)(SC + (tk * 4 + (col >> 6)) * 4) = (f32x4){inv, inv * u1, c2, bon};
        }
    }
}
__device__ __forceinline__ void phase_rwkv_prepass(const Params& p, int l, unsigned char* smem) {
    constexpr int NIT = (NTOK / 64) * 2;
    for (int k = 0; k < (NIT + NVB_ - 1) / NVB_; ++k) {
        const int it = VBID_ + k * NVB_;
        rwkv_prepass_item(p, l, it < NIT ? it : NIT - 1, smem);
    }
}

constexpr int RW_AR = 0, RW_BK = 18432, RW_UT = 27648, RW_WT = 55296, RW_MM = 82944, RW_LK = 92160, RW_LB = 97280, RW_PC = 105472, RW_CUM = 106496, RW_S0 = 114688, RW_RH = 123904;
static_assert(RW_RH + 8192 <= 2 * LDS_MAIN, "rwkv LDS layout");
__device__ __forceinline__ void rwkv_chain(const Params& p, int l, int b, int h, int dir, unsigned char* smem) {
    int tid_ = (threadIdx.x & 255); asm volatile("" : "+v"(tid_)); const int tid = tid_, lane = tid & 63, wave = tid >> 6, wr = wave >> 1, wc = wave & 1, fr = lane & 15, fq = lane >> 4;
    const int vb = VB_;
    unsigned char* BK = smem + RW_BK; unsigned char* S0b = smem + RW_S0;
    float* RH = (float*)(smem + RW_RH);
    float* CUM = (float*)(smem + RW_CUM);
    const bf16_t* PROJ = WSP(bf16_t, WS_PROJ);
    bf16_t* YO = WSP(bf16_t, WS_YRW + (size_t)dir * 16 * MiB);
    const bf16_t* WA = WSP(bf16_t, WS_WA) + (size_t)dir * NTOK * 512;
    const float* SC = WSP(float, WS_SC) + (size_t)dir * NTOK * 16;
#define RW_BUF_AR(j) (smem + RW_AR + ((j) & 1) * 9216)
#define RW_BUF_UT(j) (smem + RW_UT + ((j) % 3) * 9216)
#define RW_BUF_WT(j) (smem + RW_WT + ((j) % 3) * 9216)
#define RW_BUF_PC(j) ((float*)(smem + RW_PC + ((j) % 3) * 256))
#define RW_BUF_MM(j) (smem + RW_MM + ((j) & 1) * 4608)
#define RW_BUF_LK(j) (smem + RW_LK + ((j) & 1) * 2560)
#define RW_BUF_LB(j) ((float*)(smem + RW_LB + ((j) & 1) * 4096))
    if (vb == 0) for (int i = tid; i < 9216 / 4; i += NTHREADS) ((unsigned*)S0b)[i] = 0u;
    __syncthreads();
    if (vb == 1) {
        __builtin_amdgcn_s_setprio(2);
        const int pi = tid >> 3, pg = tid & 7;
        float mu[3][8], kkp[8], kap[8];
        {
            const float* mu_ = p.in[7] + (size_t)l * 3 * 256 + h * 64 + 8 * pg;
#pragma unroll
            for (int j = 0; j < 8; ++j) {
                mu[0][j] = mu_[j]; mu[1][j] = mu_[256 + j]; mu[2][j] = mu_[512 + j];
                kkp[j] = p.in[15][l * 256 + h * 64 + 8 * pg + j]; kap[j] = p.in[16][l * 256 + h * 64 + 8 * pg + j];
            }
        }
        u32x4 rc, kc, vc, rp, kp, vp, omw, aav; f32x4 scv;
#define RWKV_LOAD(c) do { const int s_ = (c) * 32 + pi; const int t_ = dir ? (SEQ - 1 - s_) : s_; const int tp_ = dir ? t_ + 1 : t_ - 1; const size_t tk_ = (size_t)b * SEQ + t_; \
        const bf16_t* pc_ = PROJ + tk_ * PINC; const bf16_t* pp_ = PROJ + ((size_t)b * SEQ + tp_) * PINC; const bool hp_ = (s_ > 0); const u32x4 z_ = {0u, 0u, 0u, 0u}; \
        rc = *(const u32x4*)(pc_ + C_WR + h * 64 + 8 * pg); kc = *(const u32x4*)(pc_ + C_WK + h * 64 + 8 * pg); vc = *(const u32x4*)(pc_ + C_WV + h * 64 + 8 * pg); \
        rp = hp_ ? *(const u32x4*)(pp_ + C_WR + h * 64 + 8 * pg) : z_; kp = hp_ ? *(const u32x4*)(pp_ + C_WK + h * 64 + 8 * pg) : z_; vp = hp_ ? *(const u32x4*)(pp_ + C_WV + h * 64 + 8 * pg) : z_; \
        omw = *(const u32x4*)(WA + tk_ * 512 + h * 64 + 8 * pg); aav = *(const u32x4*)(WA + tk_ * 512 + 256 + h * 64 + 8 * pg); scv = *(const f32x4*)(SC + (tk_ * 4 + h) * 4); } while (0)
        RWKV_LOAD(0);
#pragma unroll 1
        for (int it = -2; it < 128; ++it) {
            if (it + 1 >= 0 && it + 1 < 128) {
                const int cj = it + 1;
                unsigned char* AR = RW_BUF_AR(cj); unsigned char* Mm = RW_BUF_MM(cj); unsigned char* LK = RW_BUF_LK(cj); float* LBq = RW_BUF_LB(cj);
                f32x4 macc[2][2];
#pragma unroll
                for (int m = 0; m < 2; ++m)
#pragma unroll
                    for (int n = 0; n < 2; ++n) macc[m][n] = (f32x4){0.f, 0.f, 0.f, 0.f};
#pragma unroll
                for (int kk2 = 0; kk2 < 2; ++kk2) {
                    bf16x8 af[2], bf_[2];
#pragma unroll
                    for (int m = 0; m < 2; ++m) af[m] = LDS_FRAG(AR, (32 * wr + 16 * m + fr) * P72 + (32 * kk2 + 8 * fq) * 2);
#pragma unroll
                    for (int n = 0; n < 2; ++n) bf_[n] = LDS_FRAG(BK, (32 * wc + 16 * n + fr) * P72 + (32 * kk2 + 8 * fq) * 2);
#pragma unroll
                    for (int m = 0; m < 2; ++m)
#pragma unroll
                        for (int n = 0; n < 2; ++n) macc[m][n] = MFMA16(bf_[n], af[m], macc[m][n]);
                }
#pragma unroll
                for (int m = 0; m < 2; ++m)
#pragma unroll
                    for (int n = 0; n < 2; ++n) {
                        const int i = 16 * m + fr, j0 = 16 * n + 4 * fq;
                        float mv[4];
#pragma unroll
                        for (int r = 0; r < 4; ++r) { const bool keep = (wr == 0) ? (j0 + r < i) : (j0 + r <= i); mv[r] = keep ? macc[m][n][r] : 0.f; }
                        if (wr == 0 && wc == 0) {
#pragma unroll
                            for (int r = 0; r < 4; ++r) LBq[i * 32 + r * 8 + (j0 >> 2)] = mv[r];
                        } else if (wr == 0) {
                            u32x2 o; o.x = cvt_pk_bf16(mv[0], mv[1]); o.y = cvt_pk_bf16(mv[2], mv[3]);
                            *(u32x2*)(LK + i * P40 + j0 * 2) = o;
                        } else {
                            u32x2 o; o.x = cvt_pk_bf16(mv[0], mv[1]); o.y = cvt_pk_bf16(mv[2], mv[3]);
                            *(u32x2*)(Mm + i * P72 + (32 * wc + j0) * 2) = o;
                        }
                    }
            }
            __syncthreads();
            const int cq = it + 2;
            float rs[8], kk[8], ka[8], km[8];
            if (cq < 128) {
                unsigned char* Ut = RW_BUF_UT(cq);
                float a[8], bq[8], ks[8], vs[8], om[8], av[8];
                unpack8(rc, a); unpack8(rp, bq);
#pragma unroll
                for (int j = 0; j < 8; ++j) rs[j] = a[j] + mu[0][j] * (bq[j] - a[j]);
                unpack8(kc, a); unpack8(kp, bq);
#pragma unroll
                for (int j = 0; j < 8; ++j) ks[j] = a[j] + mu[1][j] * (bq[j] - a[j]);
                unpack8(vc, a); unpack8(vp, bq);
#pragma unroll
                for (int j = 0; j < 8; ++j) vs[j] = a[j] + mu[2][j] * (bq[j] - a[j]);
                unpack8(omw, om); unpack8(aav, av);
#pragma unroll
                for (int j = 0; j < 8; ++j) {
                    kk[j] = ks[j] * kkp[j] * scv.x; ka[j] = kk[j] * av[j]; km[j] = ks[j] * (1.f + (av[j] - 1.f) * kap[j]);
                    lds_st16(Ut, (8 * pg + j) * P72 + (32 + ((pi + 8 * pg) & 31)) * 2, vs[j]);
                }
                *(f32x4*)(CUM + pi * 64 + 8 * pg) = (f32x4){om[0], om[1], om[2], om[3]}; *(f32x4*)(CUM + pi * 64 + 8 * pg + 4) = (f32x4){om[4], om[5], om[6], om[7]};
                if (cq + 1 < 128) RWKV_LOAD(cq + 1);
            }
            __syncthreads();
            if (cq < 128 && tid < 64) {
                float run = 0.f;
#pragma unroll 8
                for (int i = 0; i < 32; ++i) { run += CUM[i * 64 + tid]; CUM[i * 64 + tid] = run; }
            }
            __syncthreads();
            if (cq < 128) {
                unsigned char* AR = RW_BUF_AR(cq); unsigned char* Wt = RW_BUF_WT(cq); float* PC = RW_BUF_PC(cq);
                float ci[8], cp[8], cl[8];
                {
                    const f32x4 a0 = *(const f32x4*)(CUM + pi * 64 + 8 * pg), a1 = *(const f32x4*)(CUM + pi * 64 + 8 * pg + 4);
                    const f32x4 l0 = *(const f32x4*)(CUM + 31 * 64 + 8 * pg), l1 = *(const f32x4*)(CUM + 31 * 64 + 8 * pg + 4);
                    f32x4 p0 = {0.f, 0.f, 0.f, 0.f}, p1 = {0.f, 0.f, 0.f, 0.f};
                    if (pi > 0) { p0 = *(const f32x4*)(CUM + (pi - 1) * 64 + 8 * pg); p1 = *(const f32x4*)(CUM + (pi - 1) * 64 + 8 * pg + 4); }
                    ci[0] = a0.x; ci[1] = a0.y; ci[2] = a0.z; ci[3] = a0.w; ci[4] = a1.x; ci[5] = a1.y; ci[6] = a1.z; ci[7] = a1.w;
                    cl[0] = l0.x; cl[1] = l0.y; cl[2] = l0.z; cl[3] = l0.w; cl[4] = l1.x; cl[5] = l1.y; cl[6] = l1.z; cl[7] = l1.w;
                    cp[0] = p0.x; cp[1] = p0.y; cp[2] = p0.z; cp[3] = p0.w; cp[4] = p1.x; cp[5] = p1.y; cp[6] = p1.z; cp[7] = p1.w;
                }
                float ab[8], rb[8], bb[8], kb[8];
#pragma unroll
                for (int j = 0; j < 8; ++j) {
                    const float ei = __builtin_amdgcn_exp2f(ci[j]), en = frcp(ei), ep = __builtin_amdgcn_exp2f(cp[j]), pc = __builtin_amdgcn_exp2f(cl[j]);
                    ab[j] = -kk[j] * ep; rb[j] = rs[j] * ei; bb[j] = ka[j] * en; kb[j] = km[j] * en;
                    lds_st16(Wt, (8 * pg + j) * P72 + ((pi + 8 * pg) & 31) * 2, bb[j] * pc); lds_st16(Wt, (8 * pg + j) * P72 + (32 + ((pi + 8 * pg) & 31)) * 2, kb[j] * pc);
                    if (pi == 31) PC[8 * pg + j] = pc;
                }
                *(u32x4*)(AR + pi * P72 + 16 * pg) = pack8(ab); *(u32x4*)(AR + (32 + pi) * P72 + 16 * pg) = pack8(rb);
                *(u32x4*)(BK + pi * P72 + 16 * pg) = pack8(bb); *(u32x4*)(BK + (32 + pi) * P72 + 16 * pg) = pack8(kb);
            }
            __syncthreads();
        }
#undef RWKV_LOAD
        __builtin_amdgcn_s_setprio(0);
    } else {
        f32x4 sacc[2][2];
#pragma unroll
        for (int m = 0; m < 2; ++m)
#pragma unroll
            for (int n = 0; n < 2; ++n) sacc[m][n] = (f32x4){0.f, 0.f, 0.f, 0.f};
#pragma unroll 1
        for (int it = -2; it < 128; ++it) {
            if (it < 0) { __syncthreads(); __syncthreads(); __syncthreads(); __syncthreads(); continue; }
            const int c = it;
            unsigned char* AR = RW_BUF_AR(c); unsigned char* Ut = RW_BUF_UT(c); unsigned char* Wt = RW_BUF_WT(c); float* PC = RW_BUF_PC(c);
            unsigned char* Mm = RW_BUF_MM(c); unsigned char* LK = RW_BUF_LK(c); float* LBq = RW_BUF_LB(c);
            f32x4 xacc[2][2];
#pragma unroll
            for (int m = 0; m < 2; ++m)
#pragma unroll
                for (int n = 0; n < 2; ++n) xacc[m][n] = (f32x4){0.f, 0.f, 0.f, 0.f};
#pragma unroll
            for (int kk2 = 0; kk2 < 2; ++kk2) {
                bf16x8 af[2], sf[2];
#pragma unroll
                for (int m = 0; m < 2; ++m) af[m] = LDS_FRAG(AR, (32 * wr + 16 * m + fr) * P72 + (32 * kk2 + 8 * fq) * 2);
#pragma unroll
                for (int n = 0; n < 2; ++n) sf[n] = LDS_FRAG(S0b, (32 * wc + 16 * n + fr) * P72 + (32 * kk2 + 8 * fq) * 2);
#pragma unroll
                for (int m = 0; m < 2; ++m)
#pragma unroll
                    for (int n = 0; n < 2; ++n) xacc[m][n] = MFMA16(sf[n], af[m], xacc[m][n]);
            }
            if (wr == 0) {
#pragma unroll
                for (int m = 0; m < 2; ++m) {
                    const bf16x8 lf = LDS_FRAG(LK, (16 * m + fr) * P40 + 16 * fq);
#pragma unroll
                    for (int n = 0; n < 2; ++n) {
                        const bf16x8 vf = LDS_FRAG(Ut, (32 * wc + 16 * n + fr) * P72 + (32 + 8 * ((fq + 2 * n + (fr >> 3)) & 3)) * 2);
                        xacc[m][n] = MFMA16(vf, lf, xacc[m][n]);
                        *(f32x4*)(RH + (16 * m + fr) * 64 + 32 * wc + 16 * n + 4 * fq) = xacc[m][n];
                    }
                }
            }
            __syncthreads();
            {
                const int vv = 16 * wave + (lane >> 2), q = lane & 3;
                float sreg[8];
#pragma unroll
                for (int t = 0; t < 8; ++t) sreg[t] = 0.f;
                f32x4 la[4], lb[4]; float rhv[4];
#define P4_LD(slot, i) do { la[slot] = *(const f32x4*)(LBq + (i) * 32 + q * 8); lb[slot] = *(const f32x4*)(LBq + (i) * 32 + q * 8 + 4); rhv[slot] = RH[(i) * 64 + vv]; } while (0)
#define P4_ROW(i) do { if ((i) + 3 < 32) P4_LD(((i) + 3) & 3, (i) + 3); \
                    const f32x4 l0 = la[(i) & 3], l1 = lb[(i) & 3]; \
                    const float lv[8] = {l0.x, l0.y, l0.z, l0.w, l1.x, l1.y, l1.z, l1.w}; \
                    float p0 = 0.f, p1 = 0.f; \
                    _Pragma("unroll") for (int t = 0; t < 8; t += 2) { if (4 * t < (i)) p0 += lv[t] * sreg[t]; if (4 * (t + 1) < (i)) p1 += lv[t + 1] * sreg[t + 1]; } \
                    float part = p0 + p1; \
                    part += dpp_xor1(part); part += dpp_xor2(part); \
                    const float sa = rhv[(i) & 3] + part; \
                    if (((i) & 3) == q) sreg[(i) >> 2] = sa; } while (0)
                __syncthreads();
                P4_LD(0, 0); P4_LD(1, 1); P4_LD(2, 2);
#pragma unroll
                for (int i = 0; i < 32; ++i) P4_ROW(i);
#undef P4_ROW
#undef P4_LD
#pragma unroll
                for (int t = 0; t < 8; ++t) lds_st16(Ut, vv * P72 + ((4 * t + q + 8 * (vv >> 3)) & 31) * 2, sreg[t]);
            }
            __syncthreads();
            {
#pragma unroll
                for (int m = 0; m < 2; ++m) {
                    const f32x4 pc4 = *(const f32x4*)(PC + 32 * wr + 16 * m + 4 * fq);
#pragma unroll
                    for (int n = 0; n < 2; ++n) sacc[m][n] = sacc[m][n] * pc4;
                }
#pragma unroll
                for (int kk2 = 0; kk2 < 2; ++kk2) {
                    bf16x8 uf[2], wf[2];
#pragma unroll
                    for (int n = 0; n < 2; ++n) uf[n] = LDS_FRAG(Ut, (32 * wc + 16 * n + fr) * P72 + (32 * kk2 + 8 * ((fq + 2 * n + (fr >> 3)) & 3)) * 2);
#pragma unroll
                    for (int m = 0; m < 2; ++m) wf[m] = LDS_FRAG(Wt, (32 * wr + 16 * m + fr) * P72 + (32 * kk2 + 8 * ((fq + 2 * m + (fr >> 3)) & 3)) * 2);
#pragma unroll
                    for (int m = 0; m < 2; ++m)
#pragma unroll
                        for (int n = 0; n < 2; ++n) sacc[m][n] = MFMA16(wf[m], uf[n], sacc[m][n]);
                    if (wr == 1) {
#pragma unroll
                        for (int m = 0; m < 2; ++m) {
                            const bf16x8 mf = LDS_FRAG(Mm, (16 * m + fr) * P72 + (32 * kk2 + 8 * fq) * 2);
#pragma unroll
                            for (int n = 0; n < 2; ++n) xacc[m][n] = MFMA16(uf[n], mf, xacc[m][n]);
                        }
                    }
                }
#pragma unroll
                for (int m = 0; m < 2; ++m)
#pragma unroll
                    for (int n = 0; n < 2; ++n) {
                        u32x2 o; o.x = cvt_pk_bf16(sacc[m][n][0], sacc[m][n][1]); o.y = cvt_pk_bf16(sacc[m][n][2], sacc[m][n][3]);
                        *(u32x2*)(S0b + (32 * wc + 16 * n + fr) * P72 + (32 * wr + 16 * m + 4 * fq) * 2) = o;
                    }
                if (wr == 1) {
#pragma unroll
                    for (int m = 0; m < 2; ++m) {
                        const int s = c * 32 + 16 * m + fr; const int t = dir ? (SEQ - 1 - s) : s;
                        bf16_t* yo = YO + ((size_t)b * SEQ + t) * 256 + h * 64 + 32 * wc + 4 * fq;
#pragma unroll
                        for (int n = 0; n < 2; ++n) { u32x2 o; o.x = cvt_pk_bf16(xacc[m][n][0], xacc[m][n][1]); o.y = cvt_pk_bf16(xacc[m][n][2], xacc[m][n][3]); *(u32x2*)(yo + 16 * n) = o; }
                    }
                }
            }
            __syncthreads();
        }
    }
    __syncthreads();
}

__device__ __forceinline__ void rwkv_combine_item(const Params& p, int l, int item, unsigned char* smem) {
    int tid_ = (threadIdx.x & 255); asm volatile("" : "+v"(tid_)); const int tid = tid_, lane = tid & 63, wave = tid >> 6, fr = lane & 15, fq = lane >> 4;
    constexpr int PG = 272;
    unsigned char* XG = smem;
    const bf16_t* PROJ = WSP(bf16_t, WS_PROJ);
    const bf16_t* YFw = WSP(bf16_t, WS_YRW); const bf16_t* YBw = WSP(bf16_t, WS_YRW + 16 * MiB);
    const float* SCf = WSP(float, WS_SC); const float* SCb = SCf + (size_t)NTOK * 16;
    bf16_t* HB = WSP(bf16_t, WS_HB);
    const bf16_t* gup = wt_small(p, l) + SW_GUP;
    const size_t tok0 = (size_t)item * 64;
    const int t0 = (int)(tok0 & (SEQ - 1));
    __syncthreads();
    for (int i = tid; i < 64 * 16; i += NTHREADS) {
        const int r = i >> 4, ch = i & 15;
        const u32x4 v = *(const u32x4*)(PROJ + (tok0 + r) * PINC + C_WXG + 8 * ch);
        float f[8]; unpack8(v, f);
#pragma unroll
        for (int j = 0; j < 8; ++j) f[j] = sigmoidf_(f[j]);
        *(u32x4*)(XG + r * PG + 16 * ch) = pack8(f);
    }
    __syncthreads();
    const int h = wave;
    f32x4 G[4][4];
#pragma unroll
    for (int m = 0; m < 4; ++m)
#pragma unroll
        for (int n = 0; n < 4; ++n) G[m][n] = (f32x4){0.f, 0.f, 0.f, 0.f};
#pragma unroll
    for (int kk = 0; kk < 4; ++kk) {
        bf16x8 xf[4], gf[4];
#pragma unroll
        for (int m = 0; m < 4; ++m) xf[m] = LDS_FRAG(XG, (16 * m + fr) * PG + (32 * kk + 8 * fq) * 2);
#pragma unroll
        for (int n = 0; n < 4; ++n) gf[n] = *(const bf16x8*)(gup + (size_t)(64 * h + 16 * n + fr) * 128 + 32 * kk + 8 * fq);
#pragma unroll
        for (int m = 0; m < 4; ++m)
#pragma unroll
            for (int n = 0; n < 4; ++n) G[m][n] = MFMA16(gf[n], xf[m], G[m][n]);
    }
#pragma unroll
    for (int m = 0; m < 4; ++m) {
        const int i = 16 * m + fr; const size_t tok = tok0 + i; const int t = t0 + i;
        f32x4 yv[4]; float s1 = 0.f, s2 = 0.f;
#pragma unroll
        for (int n = 0; n < 4; ++n) {
            const int col = 64 * h + 16 * n + 4 * fq;
            const u32x2 a = *(const u32x2*)(YFw + tok * 256 + col), bq = *(const u32x2*)(YBw + tok * 256 + col);
            f32x4 v = {bf_lo(a.x) + bf_lo(bq.x), bf_hi(a.x) + bf_hi(bq.x), bf_lo(a.y) + bf_lo(bq.y), bf_hi(a.y) + bf_hi(bq.y)};
            yv[n] = v; s1 += (v[0] + v[1]) + (v[2] + v[3]); s2 += (v[0] * v[0] + v[1] * v[1]) + (v[2] * v[2] + v[3] * v[3]);
        }
        s1 += __shfl_xor(s1, 16); s1 += __shfl_xor(s1, 32); s2 += __shfl_xor(s2, 16); s2 += __shfl_xor(s2, 32);
        const float mean = s1 * (1.f / 64.f), var = fmaxf(s2 * (1.f / 64.f) - mean * mean, 0.f), rstd = rsqrtf(var + 64e-5f);
        const float cf = SCf[(tok * 4 + h) * 4 + 3], cbk = SCb[(tok * 4 + h) * 4 + 3];
#pragma unroll
        for (int n = 0; n < 4; ++n) {
            const int col = 64 * h + 16 * n + 4 * fq;
            const u32x2 vc = *(const u32x2*)(PROJ + tok * PINC + C_WV + col);
            u32x2 vp = {0u, 0u}, vn = {0u, 0u};
            if (t > 0) vp = *(const u32x2*)(PROJ + (tok - 1) * PINC + C_WV + col);
            if (t < SEQ - 1) vn = *(const u32x2*)(PROJ + (tok + 1) * PINC + C_WV + col);
            const f32x4 muv = *(const f32x4*)(p.in[7] + (size_t)l * 768 + 512 + col);
            const f32x4 gn = *(const f32x4*)(p.in[18] + l * 256 + col);
            const float c4[4] = {bf_lo(vc.x), bf_hi(vc.x), bf_lo(vc.y), bf_hi(vc.y)};
            const float p4[4] = {bf_lo(vp.x), bf_hi(vp.x), bf_lo(vp.y), bf_hi(vp.y)};
            const float n4[4] = {bf_lo(vn.x), bf_hi(vn.x), bf_lo(vn.y), bf_hi(vn.y)};
            float o4[4];
#pragma unroll
            for (int r = 0; r < 4; ++r) {
                const float vf = c4[r] + muv[r] * (p4[r] - c4[r]), vb = c4[r] + muv[r] * (n4[r] - c4[r]);
                o4[r] = ((yv[n][r] - mean) * rstd * gn[r] + cf * vf + cbk * vb) * G[m][n][r];
            }
            u32x2 o; o.x = cvt_pk_bf16(o4[0], o4[1]); o.y = cvt_pk_bf16(o4[2], o4[3]);
            *(u32x2*)(HB + hb_off(tok, 256 + col)) = o;
        }
    }
}

__device__ __forceinline__ void mix_finalize_item(const Params& p, int l, int item) {
    int tid_ = (threadIdx.x & 255); asm volatile("" : "+v"(tid_)); const int tid = tid_;
    const bf16_t* PROJ = WSP(bf16_t, WS_PROJ);
    bf16_t* HB = WSP(bf16_t, WS_HB);
    const int li = tid >> 2, lc = tid & 3;
    const size_t tok = (size_t)item * 64 + li;
#pragma unroll 1
    for (int h = 0; h < 4; ++h) {
        const int col = 64 * h + 16 * lc;
#pragma unroll
        for (int mx = 0; mx < 3; ++mx) {
            const int ocol = (mx == 0) ? 0 : (mx == 1) ? 768 : 512;
            const bf16_t* yf = yt_buf(p, mx) + tok * 256 + col; bf16_t* yb = HB + hb_off(tok, ocol + col);
            const int gcol = (mx == 0) ? C_RG : (mx == 1) ? C_GOG : C_LG;
            const u32x4 f0 = *(const u32x4*)yf, f1 = *(const u32x4*)(yf + 8), b0 = *(const u32x4*)yb, b1 = *(const u32x4*)(yb + 8);
            const u32x4 g0 = *(const u32x4*)(PROJ + tok * PINC + gcol + col), g1 = *(const u32x4*)(PROJ + tok * PINC + gcol + col + 8);
            float y[16], t2[16], g[16];
            unpack8(f0, y); unpack8(f1, y + 8); unpack8(b0, t2); unpack8(b1, t2 + 8); unpack8(g0, g); unpack8(g1, g + 8);
            float s1 = 0.f, s2 = 0.f;
#pragma unroll
            for (int j = 0; j < 16; ++j) { y[j] += t2[j]; s1 += y[j]; s2 += y[j] * y[j]; }
            float o[16];
            if (mx == 2) {
#pragma unroll
                for (int j = 0; j < 16; ++j) o[j] = y[j] * geluf_(g[j]);
            } else {
                s1 += dpp_xor1(s1); s1 += dpp_xor2(s1); s2 += dpp_xor1(s2); s2 += dpp_xor2(s2);
                const float mean = (mx == 0) ? s1 * (1.f / 64.f) : 0.f;
                const float var = (mx == 0) ? fmaxf(s2 * (1.f / 64.f) - mean * mean, 0.f) : s2 * (1.f / 64.f);
                const float rstd = rsqrtf(var + 1e-6f);
                const float* gn = p.in[mx == 0 ? 6 : 26] + l * 256 + col;
#pragma unroll
                for (int j = 0; j < 16; ++j) o[j] = (y[j] - mean) * rstd * gn[j] * siluf_(g[j]);
            }
            *(u32x4*)yb = pack8(o); *(u32x4*)(yb + 8) = pack8(o + 8);
        }
    }
}

constexpr int SYNCS_RET = 1 + 64 * 3 + 1, SYNCS_GLA = 1 + 64 * 6 + 1, SYNCS_LRU = 2 + 64 * 3 + 1;
__device__ __forceinline__ void phase_mixers(const Params& p, int l, unsigned char* smem) {
    const int vb = VB_;
    for (int job_ = blockIdx.x; job_ < 256; job_ += gridDim.x) {
        const int job = __builtin_amdgcn_readfirstlane(job_);
        if (job < 64) rwkv_chain(p, l, job >> 3, (job >> 1) & 3, job & 1, smem);
        else if (vb == 0) {
            if (job < 128) ret_chain(p, l, (job - 64) >> 3, ((job - 64) >> 1) & 3, job & 1, smem);
            else if (job < 192) gla_chain(p, l, (job - 128) >> 3, ((job - 128) >> 1) & 3, job & 1, smem);
            else lru_chain(p, l, (job - 192) >> 3, ((job - 192) >> 1) & 3, job & 1, smem);
        } else {
            const int n = job < 128 ? SYNCS_RET : job < 192 ? SYNCS_GLA : SYNCS_LRU;
#pragma unroll 1
            for (int i = 0; i < n; ++i) __builtin_amdgcn_s_barrier();
        }
    }
}
__device__ __forceinline__ void phase_rwkv_combine(const Params& p, int l, unsigned char* smem) {
    constexpr int NIT = NTOK / 64;
    for (int k = 0; k < (NIT + NVB_ - 1) / NVB_; ++k) {
        const int it = VBID_ + k * NVB_;
        rwkv_combine_item(p, l, it < NIT ? it : NIT - 1, smem);
        if (it < NIT) mix_finalize_item(p, l, it);
    }
}


constexpr int N_PHASES = 22;
#ifdef DBG_SKIP_MASK
#define ST_EN(k) (!((DBG_SKIP_MASK >> (k)) & 1))
#elif !defined(ONLY_STAGE)
#define ST_EN(k) 1
#else
#define ST_EN(k) ((k) == ONLY_STAGE)
#endif
__device__ __forceinline__ void run_stage(const Params& p, int s, int l, unsigned char* smem_all) {
    unsigned char* smem = smem_all + VB_ * LDS_MAIN;
    switch (s) {
        case 10: phase_p0(p, smem); break;
        case 11: phase_norm(p, 2, p.in[33], DEPTH - 1, smem); break;
        case 0: phase_norm(p, l == 0 ? 0 : 1, p.in[2] + l * D, l - 1, smem); break;
        case 1: phase_gemm(p, G_PROJ, l, smem_all); break;
        case 9: phase_rwkv_prepass(p, l, smem); break;
        case 2: phase_mixers(p, l, smem_all); break;
        case 3: phase_rwkv_combine(p, l, smem); break;
        case 4: phase_gemm(p, G_OUT, l, smem_all); break;
        case 5: phase_ffnnorm_router(p, l, smem); break;
        case 6: { phase_topk(p, smem_all); conv_expert_items(p, l, 0, smem); conv_expert_items(p, l, 1, smem); } break;
        case 7: phase_gemm(p, G_MOE1, l, smem_all); break;
        default: phase_gemm(p, G_MOE2, l, smem_all); break;
    }
}
__device__ __forceinline__ int stage_of_phase(int ph) { if (ph == 0) return 10; if (ph == N_PHASES - 1) return 11; const int q = (ph - 1) % 10; return q == 2 ? 9 : (q < 2 ? q : q - 1); }
__device__ __forceinline__ int layer_of_phase(int ph) { return ph >= 11 ? 1 : 0; }

__global__ void __launch_bounds__(BTHREADS, 2) hybrid_fwd(Params p) {
    extern __shared__ __attribute__((aligned(16))) unsigned char smem[];
    volatile unsigned* st = (volatile unsigned*)(smem + 2 * LDS_MAIN);
    if (threadIdx.x < 16) st[threadIdx.x] = 0u;
    __syncthreads();
    unsigned* ctl = (unsigned*)(p.ws + WS_CTL);
    XcdBarrier bar; bar.bar = ctl + CW_BAR; bar.x = 0; bar.st = st;
#if ONE_LAUNCH
    bar = xcd_barrier_post(ctl + CW_BAR, st);
#if defined(DBG_DUP_MASK)
#define DUP_(S, L) if ((DBG_DUP_MASK >> (S)) & 1) { xcd_barrier(bar); run_stage(p, (S), (L), smem); }
#elif defined(DBG_DUP_STAGE)
#define DUP_(S, L) if ((S) == DBG_DUP_STAGE) { xcd_barrier(bar); run_stage(p, (S), (L), smem); }
#else
#define DUP_(S, L)
#endif
#define RUN_(S, L) { run_stage(p, (S), (L), smem); DUP_(S, L) xcd_barrier(bar); }
#define LAYER_(L) RUN_(0, L) RUN_(1, L) RUN_(9, L) RUN_(2, L) RUN_(3, L) RUN_(4, L) RUN_(5, L) RUN_(6, L) RUN_(7, L) RUN_(8, L)
    run_stage(p, 10, 0, smem);
    LAYER_(0)
    LAYER_(1)
    run_stage(p, 11, 1, smem);
#else
#pragma unroll 1
    for (int ph = p.phase_lo; ph < p.phase_hi; ++ph) run_stage(p, stage_of_phase(ph), __builtin_amdgcn_readfirstlane(layer_of_phase(ph)), smem);
#endif
}

extern "C" void kernel_launch(void* const* d_in, const int* in_sizes, int n_in, void* d_out, int out_size, void* d_ws, size_t ws_size, hipStream_t stream) {
    static int grid = 0;
    if (grid == 0) {
        if (n_in != 34 || out_size != NTOK * D || ws_size < WS_END) { fprintf(stderr, "kernel_launch: unexpected shapes (n_in %d out %d ws %zu need %zu)\n", n_in, out_size, ws_size, (size_t)WS_END); grid = -1; return; }
        int dev = 0, cus = 0, per_cu = 0;
        hipGetDevice(&dev);
        hipDeviceGetAttribute(&cus, hipDeviceAttributeMultiprocessorCount, dev);
        hipFuncSetAttribute((const void*)hybrid_fwd, hipFuncAttributeMaxDynamicSharedMemorySize, LDS_BYTES);
        hipOccupancyMaxActiveBlocksPerMultiprocessor(&per_cu, (const void*)hybrid_fwd, BTHREADS, LDS_BYTES);
        if (per_cu < 1) { fprintf(stderr, "kernel_launch: occupancy query says %d blocks/CU\n", per_cu); per_cu = 1; }
        if (per_cu > 1) per_cu = 1;
        grid = cus * per_cu;
        (void)hipGetLastError();
    }
    if (grid < 0) return;
    hipMemsetAsync((char*)d_ws + WS_CTL, 0, 1 * MiB, stream);
    Params p{};
    for (int i = 0; i < 34; ++i) p.in[i] = (const float*)d_in[i];
    p.out = (float*)d_out; p.ws = (unsigned char*)d_ws;
#if ONE_LAUNCH
    p.phase_lo = 0; p.phase_hi = N_PHASES;
    void* args[] = {&p};
    hipError_t e = hipLaunchCooperativeKernel((const void*)hybrid_fwd, dim3(grid), dim3(BTHREADS), args, LDS_BYTES, stream);
    if (e != hipSuccess) fprintf(stderr, "cooperative launch failed: %s (grid %d)\n", hipGetErrorString(e), grid);
#else
    for (int ph = 0; ph < N_PHASES; ++ph) {
        p.phase_lo = ph; p.phase_hi = ph + 1;
        hipLaunchKernelGGL(hybrid_fwd, dim3(grid), dim3(BTHREADS), LDS_BYTES, stream, p);
    }
#endif
}
```

```cpp
#include <hip/hip_runtime.h>
#include <stdint.h>
#include <stdio.h>

#ifndef ONE_LAUNCH
#define ONE_LAUNCH 1
#endif

typedef unsigned short bf16_t;
typedef short bf16x8 __attribute__((ext_vector_type(8)));
typedef float f32x4 __attribute__((ext_vector_type(4)));
typedef float f32x2 __attribute__((ext_vector_type(2)));
typedef unsigned u32x4 __attribute__((ext_vector_type(4)));
typedef unsigned u32x2 __attribute__((ext_vector_type(2)));

constexpr int D = 1024, BATCH = 8, SEQ = 4096, NTOK = BATCH * SEQ, DEPTH = 2;
constexpr int INC = 3344;
constexpr int PINC = 3456;
constexpr int C_RQ = 0, C_RK = 256, C_RV = 512, C_RG = 768, C_WR = 1024, C_WK = 1280, C_WV = 1536, C_WXW = 1792, C_WXA = 1856,
              C_WXG = 1920, C_LX = 2048, C_LG = 2304, C_GQ = 2560, C_GK = 2688, C_GV = 2816, C_GOG = 3072, C_GXA = 3328;
constexpr int NE = 16, CAP = 512;
constexpr int NTHREADS = 256;
constexpr int BTHREADS = 512;
#define VB_   (__builtin_amdgcn_readfirstlane((int)(threadIdx.x >> 8)))
#define VBID_ ((int)blockIdx.x + (int)gridDim.x * VB_)
#define NVB_  (2 * (int)gridDim.x)
constexpr int LDS_MAIN = 73728, LDS_BYTES = 2 * LDS_MAIN + 64;

constexpr size_t MiB = 1u << 20;
constexpr size_t WS_CTL = 0;
constexpr size_t WS_WTIN = 1 * MiB;
constexpr size_t WS_WTOUT = 15 * MiB;
constexpr size_t WS_WSMALL = 19 * MiB;
constexpr size_t WS_AFF = 20 * MiB;
constexpr size_t WS_IDX = 22 * MiB;
constexpr size_t WS_GATE = 22 * MiB + 256 * 1024;
constexpr size_t WS_BONC = 22 * MiB + 512 * 1024;
constexpr size_t WS_INV = 24 * MiB;
constexpr size_t WS_WTEXP = 26 * MiB;
constexpr size_t WS_HB = 122 * MiB;
constexpr size_t WS_PROJ = 186 * MiB;
constexpr size_t WS_YT = 402 * MiB;
constexpr size_t WS_HID = WS_PROJ;
constexpr size_t WS_OUTB = WS_PROJ + 128 * MiB;
constexpr size_t WS_ROT = 442 * MiB;
constexpr size_t WS_WA = 450 * MiB;
constexpr size_t WS_YRW = 514 * MiB;
constexpr size_t WS_END = 546 * MiB;
constexpr size_t WS_SC = WS_AFF;
constexpr int SW_WUP = 0;
constexpr int SW_AUP = 32768;
constexpr int SW_GUP = 65536;
constexpr int SW_LRU = 98304;
constexpr int SW_LAYER = 262144;
constexpr int CW_QUEUE = 16;
constexpr int CW_BAR = 4096;

struct Params {
    const float* in[34];
    float* out;
    unsigned char* ws;
    int phase_lo, phase_hi;
};

__device__ __forceinline__ int opaque_tid() { int t = (threadIdx.x & 255); asm volatile("" : "+v"(t)); return t; }
typedef __bf16 bf16x2v __attribute__((ext_vector_type(2)));
__device__ __forceinline__ unsigned cvt_pk_bf16(float lo, float hi) { const f32x2 f = {lo, hi}; const bf16x2v b = __builtin_convertvector(f, bf16x2v); return __builtin_bit_cast(unsigned, b); }
__device__ __forceinline__ float bf_lo(unsigned u) { return __uint_as_float(u << 16); }
__device__ __forceinline__ float bf_hi(unsigned u) { return __uint_as_float(u & 0xffff0000u); }
__device__ __forceinline__ bf16_t f2bf(float f) { return (bf16_t)(cvt_pk_bf16(f, 0.f) & 0xffffu); }
__device__ __forceinline__ float frcp(float x) { return __builtin_amdgcn_rcpf(x); }
__device__ __forceinline__ float sigmoidf_(float x) { return frcp(1.f + __expf(-x)); }
__device__ __forceinline__ float siluf_(float x) { return x * sigmoidf_(x); }
__device__ __forceinline__ float softplusf_(float x) { return fmaxf(x, 0.f) + __logf(1.f + __expf(-fabsf(x))); }
__device__ __forceinline__ float tanhf_(float x) { float xc = fminf(fmaxf(x, -15.f), 15.f); float t = __expf(2.f * xc); return (t - 1.f) * frcp(t + 1.f); }
__device__ __forceinline__ float geluf_(float x) { return 0.5f * x * (1.f + tanhf_(0.7978845608028654f * (x + 0.044715f * x * x * x))); }
__device__ __forceinline__ void unpack8(const u32x4 v, float* f) {
    f[0] = bf_lo(v.x); f[1] = bf_hi(v.x); f[2] = bf_lo(v.y); f[3] = bf_hi(v.y); f[4] = bf_lo(v.z); f[5] = bf_hi(v.z); f[6] = bf_lo(v.w); f[7] = bf_hi(v.w);
}
__device__ __forceinline__ u32x4 pack8(const float* f) {
    u32x4 v; v.x = cvt_pk_bf16(f[0], f[1]); v.y = cvt_pk_bf16(f[2], f[3]); v.z = cvt_pk_bf16(f[4], f[5]); v.w = cvt_pk_bf16(f[6], f[7]); return v;
}
__device__ __forceinline__ float wave_sum(float v) {
#pragma unroll
    for (int o = 1; o < 64; o <<= 1) v += __shfl_xor(v, o);
    return v;
}
__device__ __forceinline__ float dpp_xor1(float x) { return __int_as_float(__builtin_amdgcn_mov_dpp(__float_as_int(x), 0xB1, 0xF, 0xF, true)); }
__device__ __forceinline__ float dpp_hmirror(float x) { return __int_as_float(__builtin_amdgcn_mov_dpp(__float_as_int(x), 0x141, 0xF, 0xF, true)); }
__device__ __forceinline__ float dpp_xor2(float x) { return __int_as_float(__builtin_amdgcn_mov_dpp(__float_as_int(x), 0x4E, 0xF, 0xF, true)); }
#define MFMA16(a, b, c) __builtin_amdgcn_mfma_f32_16x16x32_bf16((a), (b), (c), 0, 0, 0)
#define LDS_FRAG(base, byteoff) (*(const bf16x8*)((base) + (byteoff)))
__device__ __forceinline__ u32x4 pair_swap16(const u32x2 a, const u32x2 b) {
    const u32x2 r0 = __builtin_amdgcn_permlane16_swap(a.x, b.x, false, false), r1 = __builtin_amdgcn_permlane16_swap(a.y, b.y, false, false);
    return (u32x4){r0.x, r1.x, r0.y, r1.y};
}
__device__ __forceinline__ int swz8(int fq) { return ((fq & 1) << 4) | ((fq >> 1) << 3); }

#define XB_TMO      128
#define XB_XCNT(j)  (256  + 64 * (j))
#define XB_XSUB(j)  (1280 + 64 * (j))
#define XB_XGEN(j)  (2304 + 64 * (j))
#define XB_TOP      3328
#define XB_TOPGEN   3392
#define XB_SPIN_CAP (1u << 22)
__device__ __forceinline__ unsigned xb_ld(unsigned* p) { return __hip_atomic_load(p, __ATOMIC_RELAXED, __HIP_MEMORY_SCOPE_AGENT); }
__device__ __forceinline__ unsigned xb_add(unsigned* p, unsigned v) { return __hip_atomic_fetch_add(p, v, __ATOMIC_RELAXED, __HIP_MEMORY_SCOPE_AGENT); }
__device__ __forceinline__ unsigned xb_xcc_id() { return (unsigned)__builtin_amdgcn_s_getreg((3 << 11) | 20) & 0xFu; }
#define XB_SPIN(cond, bar) do { unsigned _sp = 0; while (cond) { __builtin_amdgcn_s_sleep(1); \
    if ((++_sp & 255u) == 0u) { if (xb_ld(&(bar)[XB_TMO])) break; if (_sp > XB_SPIN_CAP) { atomicAdd(&(bar)[XB_TMO], 1u); break; } } } } while (0)
struct XcdBarrier { unsigned* bar; unsigned x; volatile unsigned* st; };
__device__ __forceinline__ XcdBarrier xcd_barrier_post(unsigned* bar, volatile unsigned* st) {
    XcdBarrier b; b.bar = bar; b.x = xb_xcc_id(); b.st = st;
    if (threadIdx.x == 0) (void)xb_add(&bar[XB_XCNT(b.x)], 1u);
    return b;
}
__device__ __forceinline__ void xcd_barrier_complete(unsigned* bar, unsigned x, unsigned& nloc, unsigned& nx) {
    const unsigned G = gridDim.x;
    unsigned sum, cnt, mine, sp = 0u;
    for (;;) {
        sum = 0u; cnt = 0u; mine = 0u;
#pragma unroll
        for (unsigned j = 0; j < 16; ++j) { const unsigned c = xb_ld(&bar[XB_XCNT(j)]); sum += c; cnt += (c > 0u) ? 1u : 0u; mine = (j == x) ? c : mine; }
        if (sum == G) break;
        __builtin_amdgcn_s_sleep(1);
        if ((++sp & 255u) == 0u) { if (xb_ld(&bar[XB_TMO])) break; if (sp > XB_SPIN_CAP) { atomicAdd(&bar[XB_TMO], 1u); break; } }
    }
    nloc = mine > 0u ? mine : 1u; nx = cnt > 0u ? cnt : 1u;
}
__device__ __forceinline__ void xcd_barrier(const XcdBarrier& b) {
    asm volatile("s_waitcnt vmcnt(0)" ::: "memory");
    __syncthreads();
    if (threadIdx.x == 0) {
        unsigned* bar = b.bar;
        __builtin_amdgcn_s_waitcnt(0);
        unsigned nloc = b.st[0], nx = b.st[1];
        if (nloc == 0u) { xcd_barrier_complete(bar, b.x, nloc, nx); b.st[0] = nloc; b.st[1] = nx; }
        const unsigned old = xb_add(&bar[XB_XSUB(b.x)], 1u);
        const unsigned gen = old / nloc;
        if (old + 1u == (gen + 1u) * nloc) {
            __builtin_amdgcn_fence(__ATOMIC_RELEASE, "agent");
            asm volatile("s_waitcnt vmcnt(0)" ::: "memory");
            const unsigned og = xb_add(&bar[XB_TOP], 1u);
            const unsigned tg = og / nx;
            if (og + 1u == (tg + 1u) * nx) xb_add(&bar[XB_TOPGEN], 1u);
            else XB_SPIN(xb_ld(&bar[XB_TOPGEN]) == tg, bar);
            __builtin_amdgcn_fence(__ATOMIC_ACQUIRE, "");
            xb_add(&bar[XB_XGEN(b.x)], 1u);
            asm volatile("s_waitcnt vmcnt(0)" ::: "memory");
        } else {
            XB_SPIN(xb_ld(&bar[XB_XGEN(b.x)]) == gen, bar);
            __builtin_amdgcn_fence(__ATOMIC_ACQUIRE, "agent");
            asm volatile("s_waitcnt vmcnt(0)" ::: "memory");
        }
    }
    __syncthreads();
}

#define WSP(T, off) ((T*)(p.ws + (off)))
__device__ __forceinline__ bf16_t* wt_in(const Params& p, int l) { return WSP(bf16_t, WS_WTIN + (size_t)l * 7 * MiB); }
__device__ __forceinline__ bf16_t* wt_out(const Params& p, int l) { return WSP(bf16_t, WS_WTOUT + (size_t)l * 2 * MiB); }
__device__ __forceinline__ bf16_t* wt_small(const Params& p, int l) { return WSP(bf16_t, WS_WSMALL) + (size_t)l * SW_LAYER; }
__device__ __forceinline__ size_t hb_off(size_t tok, int col) { return ((size_t)(col >> 5) * NTOK + tok) * 32 + (col & 31); }
__device__ __forceinline__ size_t hid_off(size_t row, int col) { return ((size_t)(col >> 5) * 65536 + row) * 32 + (col & 31); }
__device__ __forceinline__ bf16_t* yt_buf(const Params& p, int i) { return WSP(bf16_t, WS_YT + (size_t)i * 16 * MiB); }

__device__ __forceinline__ void transpose_tile(const float* __restrict__ src, int lds_, int K, int N, bf16_t* __restrict__ dst, int ldd, int kt, int nt, float* tile, int kb = 0) {
    int tid_ = (threadIdx.x & 255); asm volatile("" : "+v"(tid_)); const int tid = tid_, k0 = kt * 64, n0 = nt * 64;
#pragma unroll
    for (int i = 0; i < 4; ++i) {
        const int r = (tid >> 4) + 16 * i, c = (tid & 15) * 4;
        f32x4 v = {0.f, 0.f, 0.f, 0.f};
        if (k0 + r < K) {
            if (n0 + c + 3 < N) v = *(const f32x4*)(src + (size_t)(k0 + r) * lds_ + n0 + c);
            else { if (n0 + c < N) v.x = src[(size_t)(k0 + r) * lds_ + n0 + c]; if (n0 + c + 1 < N) v.y = src[(size_t)(k0 + r) * lds_ + n0 + c + 1]; if (n0 + c + 2 < N) v.z = src[(size_t)(k0 + r) * lds_ + n0 + c + 2]; }
        }
        tile[r * 65 + c] = v.x; tile[r * 65 + c + 1] = v.y; tile[r * 65 + c + 2] = v.z; tile[r * 65 + c + 3] = v.w;
    }
    __syncthreads();
    {
        const int n = tid >> 2, kc = (tid & 3) * 16;
        if (n0 + n < N) {
            float f[16];
#pragma unroll
            for (int j = 0; j < 16; ++j) f[j] = tile[(kc + j) * 65 + n];
            u32x4 a = pack8(f), b = pack8(f + 8);
            bf16_t* o = kb ? dst + ((size_t)((k0 + kc) >> 5) * kb + n0 + n) * 32 + ((k0 + kc) & 31) : dst + (size_t)(n0 + n) * ldd + k0 + kc;
            *(u32x4*)o = a; *(u32x4*)(o + 8) = b;
        }
    }
    __syncthreads();
}

__device__ __forceinline__ void phase_p0(const Params& p, unsigned char* smem) {
    float* tile = (float*)smem;
    const int bid = VBID_, nb = NVB_;
    constexpr int J_IN = 16 * 53, J_OUT = 256, J_WUP = 8, J_AUP = 8, J_GUP = 8, J_LRU = 16, J_L = J_IN + J_OUT + J_WUP + J_AUP + J_GUP + J_LRU;
    for (int k = 0; k < (2 * J_L + nb - 1) / nb; ++k) {
        const int job = bid + k * nb;
        if (job >= 2 * J_L) { __syncthreads(); __syncthreads(); continue; }
        const int l = job / J_L; int r = job % J_L;
        bf16_t* sw = wt_small(p, l);
        if (r < J_IN) { transpose_tile(p.in[3] + (size_t)l * D * INC, INC, D, INC, wt_in(p, l), D, r / 53, r % 53, tile, INC); continue; } r -= J_IN;
        if (r < J_OUT) { transpose_tile(p.in[4] + (size_t)l * D * D, D, D, D, wt_out(p, l), D, r / 16, r % 16, tile, D); continue; } r -= J_OUT;
        if (r < J_WUP) { const int dir = r / 4; transpose_tile(p.in[11] + (size_t)(l * 2 + dir) * 64 * 256, 256, 64, 256, sw + SW_WUP + dir * 16384, 64, 0, r % 4, tile); continue; } r -= J_WUP;
        if (r < J_AUP) { const int dir = r / 4; transpose_tile(p.in[13] + (size_t)(l * 2 + dir) * 64 * 256, 256, 64, 256, sw + SW_AUP + dir * 16384, 64, 0, r % 4, tile); continue; } r -= J_AUP;
        if (r < J_GUP) { transpose_tile(p.in[14] + (size_t)l * 128 * 256, 256, 128, 256, sw + SW_GUP, 128, r / 4, r % 4, tile); continue; } r -= J_GUP;
        { transpose_tile(p.in[21] + (size_t)(l * 16 + r) * 4096, 64, 64, 64, sw + SW_LRU + r * 4096, 64, 0, 0, tile); }
    }
}

__device__ __forceinline__ void phase_rotary_table(const Params& p) {
    const int bid = VBID_, nb = NVB_;
    const int* pos = (const int*)p.in[1];
    f32x2* rot = WSP(f32x2, WS_ROT);
    for (int i = bid * NTHREADS + opaque_tid(); i < NTOK * 32; i += nb * NTHREADS) {
        const int tok = i >> 5, j = i & 31;
        const float inv = exp2f(-(float)j * (13.287712379549449f / 32.f));
        const float ang = (float)pos[tok] * inv;
        float s, c; sincosf(ang, &s, &c);
        rot[i] = (f32x2){c, s};
    }
}

__device__ __forceinline__ void conv_expert_items(const Params& p, int l, unsigned char* smem, int vbid, int nvb) {
    float* tile = (float*)smem;
    bf16_t* dstbase = WSP(bf16_t, WS_WTEXP);
    constexpr int nitems = 48 * 256;
    int tid_ = (threadIdx.x & 255); asm volatile("" : "+v"(tid_)); const int tid = tid_;
    const int r0 = tid >> 4, c0 = (tid & 15) * 4;
    const int n = tid >> 2, kc = (tid & 3) * 16;
    f32x4 v[4];
#define CONV_LOAD(it_) do { const int mi_ = (it_) >> 8, e_ = mi_ / 3, w_ = mi_ - 3 * e_; \
        const float* s_ = p.in[30 + w_] + ((size_t)l * NE + e_) * D * D + (size_t)((((it_) & 255) >> 4) * 64) * D + ((it_) & 15) * 64; \
        _Pragma("unroll") for (int i = 0; i < 4; ++i) v[i] = *(const f32x4*)(s_ + (size_t)(r0 + 16 * i) * D + c0); } while (0)
    const int last = nitems - 1, trips = (nitems + nvb - 1) / nvb;
    { const int itf = vbid < nitems ? vbid : last; CONV_LOAD(itf); }
    __syncthreads();
    for (int k = 0; k < trips; ++k) {
        const int itr = vbid + k * nvb, it = itr < nitems ? itr : last;
        const int mi = it >> 8, t = it & 255;
#pragma unroll
        for (int i = 0; i < 4; ++i) { const int r = r0 + 16 * i; tile[r * 65 + c0] = v[i].x; tile[r * 65 + c0 + 1] = v[i].y; tile[r * 65 + c0 + 2] = v[i].z; tile[r * 65 + c0 + 3] = v[i].w; }
        __syncthreads();
        if (k + 1 < trips) { const int itn = itr + nvb < nitems ? itr + nvb : last; CONV_LOAD(itn); }
        {
            float f[16];
#pragma unroll
            for (int j = 0; j < 16; ++j) f[j] = tile[(kc + j) * 65 + n];
            const int k0 = (t >> 4) * 64, n0 = (t & 15) * 64;
            bf16_t* o = dstbase + (size_t)mi * D * D + ((size_t)((k0 + kc) >> 5) * D + n0 + n) * 32 + ((k0 + kc) & 31);
            *(u32x4*)o = pack8(f); *(u32x4*)(o + 8) = pack8(f + 8);
        }
        __syncthreads();
    }
#undef CONV_LOAD
}

__device__ __forceinline__ void phase_norm(const Params& p, int mode, const float* __restrict__ wgt, int l, unsigned char* smem) {
    int tid_ = (threadIdx.x & 255); asm volatile("" : "+v"(tid_)); const int tid = tid_, lane = tid & 63, wave = tid >> 6;
    float* rw = (float*)smem;
    if (mode == 3) {
        const float* rsrc = p.in[28] + (size_t)l * D * NE;
        for (int i = tid; i < D * NE; i += NTHREADS) {
            const int d = i >> 4, e = i & 15;
            const int j = d >> 8, ln = (d & 255) >> 2, ii = d & 3;
            rw[((j * 4 + ii) * 16 + e) * 64 + ln] = rsrc[i];
        }
        __syncthreads();
    }
    const float* xin = (mode == 0) ? p.in[0] : p.out;
    bf16_t* HB = WSP(bf16_t, WS_HB);
    const int* INV = WSP(int, WS_INV);
    const bf16_t* OUTB = WSP(bf16_t, WS_OUTB);
    const int gw = VBID_ * 4 + wave, ngw = NVB_ * 4;
    for (int row = gw; row < NTOK; row += ngw) {
        f32x4 v[4];
#pragma unroll
        for (int j = 0; j < 4; ++j) v[j] = *(const f32x4*)(xin + (size_t)row * D + 4 * lane + 256 * j);
        if (mode == 1 || mode == 2) {
            const int b = row >> 12;
            const int myinv = (lane < 16) ? INV[(size_t)row * 16 + lane] : -1;
#pragma unroll 1
            for (int e = 0; e < 16; ++e) {
                const int slot = __shfl(myinv, e);
                if (slot >= 0) {
                    const bf16_t* orow = OUTB + ((size_t)(b * 16 + e) * CAP + slot) * D;
#pragma unroll
                    for (int j = 0; j < 4; ++j) {
                        const u32x2 o = *(const u32x2*)(orow + 4 * lane + 256 * j);
                        v[j].x += bf_lo(o.x); v[j].y += bf_hi(o.x); v[j].z += bf_lo(o.y); v[j].w += bf_hi(o.y);
                    }
                }
            }
            if (mode == 1) {
#pragma unroll
                for (int j = 0; j < 4; ++j) *(f32x4*)(p.out + (size_t)row * D + 4 * lane + 256 * j) = v[j];
            }
        }
        float ss = 0.f;
#pragma unroll
        for (int j = 0; j < 4; ++j) ss += v[j].x * v[j].x + v[j].y * v[j].y + v[j].z * v[j].z + v[j].w * v[j].w;
        ss = wave_sum(ss);
        const float rstd = rsqrtf(ss * (1.f / D) + 1e-6f);
#pragma unroll
        for (int j = 0; j < 4; ++j) { const f32x4 w = *(const f32x4*)(wgt + 4 * lane + 256 * j); v[j] = v[j] * rstd * w; }
        if (mode == 2) {
#pragma unroll
            for (int j = 0; j < 4; ++j) *(f32x4*)(p.out + (size_t)row * D + 4 * lane + 256 * j) = v[j];
        } else {
#pragma unroll
            for (int j = 0; j < 4; ++j) { u32x2 o; o.x = cvt_pk_bf16(v[j].x, v[j].y); o.y = cvt_pk_bf16(v[j].z, v[j].w); *(u32x2*)(HB + hb_off(row, 4 * lane + 256 * j)) = o; }
        }
        if (mode == 3) {
            float lg[16];
#pragma unroll
            for (int e = 0; e < 16; ++e) lg[e] = 0.f;
#pragma unroll
            for (int j = 0; j < 4; ++j) {
                const float xv[4] = {v[j].x, v[j].y, v[j].z, v[j].w};
#pragma unroll
                for (int ii = 0; ii < 4; ++ii) {
#pragma unroll
                    for (int e = 0; e < 16; ++e) lg[e] += xv[ii] * rw[((j * 4 + ii) * 16 + e) * 64 + lane];
                    __builtin_amdgcn_sched_barrier(0);
                }
            }
            float mx = -1e30f;
#pragma unroll
            for (int e = 0; e < 16; ++e) { lg[e] = wave_sum(lg[e]) + p.in[29][l * NE + e]; mx = fmaxf(mx, lg[e]); }
            float sum = 0.f;
#pragma unroll
            for (int e = 0; e < 16; ++e) { lg[e] = __expf(lg[e] - mx); sum += lg[e]; }
            const float inv = 1.f / sum;
            float mine = 0.f;
#pragma unroll
            for (int e = 0; e < 16; ++e) mine = (lane == e) ? lg[e] * inv : mine;
            if (lane < 16) { const int b = row >> 12, t = row & 4095; WSP(float, WS_AFF)[((size_t)b * NE + lane) * SEQ + t] = mine; }
        }
    }
}

__device__ __forceinline__ void phase_ffnnorm_router(const Params& p, int l, unsigned char* smem) {
    int tid_ = (threadIdx.x & 255); asm volatile("" : "+v"(tid_)); const int tid = tid_, lane = tid & 63, wave = tid >> 6, fr = lane & 15, fq = lane >> 4;
    constexpr int PR = 2064;
    unsigned char* RWh = smem; unsigned char* RWl = smem + 16 * PR;
    const float* wgt = p.in[27] + l * D;
    {
        const float* rsrc = p.in[28] + (size_t)l * D * NE;
        for (int i = tid; i < D * NE; i += NTHREADS) {
            const int k = i >> 4, e = i & 15;
            const float v = rsrc[i] * wgt[k];
            const unsigned hb = cvt_pk_bf16(v, 0.f) & 0xffffu;
            const float hf = __uint_as_float(hb << 16);
            *(bf16_t*)(RWh + e * PR + k * 2) = (bf16_t)hb;
            *(bf16_t*)(RWl + e * PR + k * 2) = (bf16_t)(cvt_pk_bf16(v - hf, 0.f) & 0xffffu);
        }
        __syncthreads();
    }
    bf16_t* HB = WSP(bf16_t, WS_HB);
    float* AFF = WSP(float, WS_AFF);
    const int gw = VBID_ * 4 + wave, ngw = NVB_ * 4;
    for (int grp = gw; grp < NTOK / 16; grp += ngw) {
        const size_t row = (size_t)grp * 16 + fr;
        const float* xr = p.out + row * D + 8 * fq;
        f32x4 acc = {0.f, 0.f, 0.f, 0.f};
        float ss = 0.f;
#pragma unroll 4
        for (int ks = 0; ks < 32; ++ks) {
            const f32x4 x0 = *(const f32x4*)(xr + 32 * ks), x1 = *(const f32x4*)(xr + 32 * ks + 4);
            const float xv[8] = {x0.x, x0.y, x0.z, x0.w, x1.x, x1.y, x1.z, x1.w};
            unsigned hp[4], lp[4];
#pragma unroll
            for (int j = 0; j < 4; ++j) {
                ss += xv[2 * j] * xv[2 * j] + xv[2 * j + 1] * xv[2 * j + 1];
                hp[j] = cvt_pk_bf16(xv[2 * j], xv[2 * j + 1]);
                lp[j] = cvt_pk_bf16(xv[2 * j] - bf_lo(hp[j]), xv[2 * j + 1] - bf_hi(hp[j]));
            }
            const u32x4 ahu = {hp[0], hp[1], hp[2], hp[3]}, alu = {lp[0], lp[1], lp[2], lp[3]};
            const bf16x8 ah = __builtin_bit_cast(bf16x8, ahu), al = __builtin_bit_cast(bf16x8, alu);
            const bf16x8 bh = LDS_FRAG(RWh, fr * PR + (32 * ks + 8 * fq) * 2), bl = LDS_FRAG(RWl, fr * PR + (32 * ks + 8 * fq) * 2);
            acc = MFMA16(bh, ah, acc); acc = MFMA16(bh, al, acc); acc = MFMA16(bl, ah, acc);
        }
        ss += __shfl_xor(ss, 16); ss += __shfl_xor(ss, 32);
        const float rstd = rsqrtf(ss * (1.f / D) + 1e-6f);
        float lg[4], mx = -1e30f;
#pragma unroll
        for (int r = 0; r < 4; ++r) { lg[r] = acc[r] * rstd + p.in[29][l * NE + 4 * fq + r]; mx = fmaxf(mx, lg[r]); }
        mx = fmaxf(mx, __shfl_xor(mx, 16)); mx = fmaxf(mx, __shfl_xor(mx, 32));
        float sum = 0.f;
#pragma unroll
        for (int r = 0; r < 4; ++r) { lg[r] = __expf(lg[r] - mx); sum += lg[r]; }
        sum += __shfl_xor(sum, 16); sum += __shfl_xor(sum, 32);
        const float inv = 1.f / sum;
        {
            const int b = (int)(row >> 12), t = (int)(row & 4095);
#pragma unroll
            for (int r = 0; r < 4; ++r) AFF[((size_t)b * NE + 4 * fq + r) * SEQ + t] = lg[r] * inv;
        }
        bf16_t* hr = HB + row * 32 + 8 * fq;
#pragma unroll 4
        for (int ks = 0; ks < 32; ++ks) {
            const f32x4 x0 = *(const f32x4*)(xr + 32 * ks), x1 = *(const f32x4*)(xr + 32 * ks + 4);
            const f32x4 w0 = *(const f32x4*)(wgt + 32 * ks + 8 * fq), w1 = *(const f32x4*)(wgt + 32 * ks + 8 * fq + 4);
            u32x4 o;
            o.x = cvt_pk_bf16(x0.x * rstd * w0.x, x0.y * rstd * w0.y); o.y = cvt_pk_bf16(x0.z * rstd * w0.z, x0.w * rstd * w0.w);
            o.z = cvt_pk_bf16(x1.x * rstd * w1.x, x1.y * rstd * w1.y); o.w = cvt_pk_bf16(x1.z * rstd * w1.z, x1.w * rstd * w1.w);
            *(u32x4*)(hr + (size_t)ks * NTOK * 32) = o;
        }
    }
}

__device__ __forceinline__ void phase_topk(const Params& p, unsigned char* smem) {
    int tid_ = threadIdx.x; asm volatile("" : "+v"(tid_)); const int tid = tid_, lane = tid & 63, wave = tid >> 6;
    int* scnt = (int*)smem;
    const float* AFF = WSP(float, WS_AFF);
    int* IDX = WSP(int, WS_IDX); float* GATE = WSP(float, WS_GATE); int* INV = WSP(int, WS_INV);
    for (int be = blockIdx.x; be < BATCH * NE; be += gridDim.x) {
        const int b = be / NE, e = be % NE;
        unsigned key[8];
#pragma unroll
        for (int j = 0; j < 8; ++j) key[j] = __float_as_uint(AFF[(size_t)be * SEQ + j * 512 + tid]);
        unsigned prefix = 0u; int remaining = CAP;
#pragma unroll 1
        for (int bit = 30; bit >= 0; --bit) {
            const unsigned cand = prefix | (1u << bit);
            int c = 0;
#pragma unroll
            for (int j = 0; j < 8; ++j) c += ((key[j] >> bit) == (cand >> bit)) ? 1 : 0;
            c = (int)wave_sum((float)c);
            __syncthreads();
            if (lane == 0) scnt[wave] = c;
            __syncthreads();
            const int tot = scnt[0] + scnt[1] + scnt[2] + scnt[3] + scnt[4] + scnt[5] + scnt[6] + scnt[7];
            if (tot >= remaining) prefix = cand; else remaining -= tot;
        }
        int gt_base = 0, eq_base = 0;
#pragma unroll 1
        for (int j = 0; j < 8; ++j) {
            const bool gt = key[j] > prefix, eq = key[j] == prefix;
            const unsigned long long mg = __ballot(gt), me = __ballot(eq);
            const unsigned long long lower = (lane == 0) ? 0ull : (~0ull >> (64 - lane));
            const int pg = __popcll(mg & lower), pe = __popcll(me & lower);
            __syncthreads();
            if (lane == 0) { scnt[wave] = __popcll(mg); scnt[8 + wave] = __popcll(me); }
            __syncthreads();
            int wg = 0, we = 0, tg = 0, te = 0;
#pragma unroll
            for (int w = 0; w < 8; ++w) { const int a = scnt[w], c2 = scnt[8 + w]; if (w < wave) { wg += a; we += c2; } tg += a; te += c2; }
            const int g_before = gt_base + wg + pg, e_before = eq_base + we + pe;
            const int t = j * 512 + tid;
            int slot = -1;
            if (gt) slot = g_before + min(e_before, remaining);
            else if (eq && e_before < remaining) slot = g_before + e_before;
            if (slot >= 0) { IDX[(size_t)be * CAP + slot] = t; GATE[(size_t)be * CAP + slot] = __uint_as_float(key[j]); }
            INV[((size_t)b * SEQ + t) * 16 + e] = slot;
            gt_base += tg; eq_base += te;
        }
        __syncthreads();
    }
}

enum { G_PROJ = 0, G_OUT = 1, G_MOE1 = 2, G_MOE2 = 3 };
struct GemmJob {
    const bf16_t* A; const bf16_t* B;
    int mode, mt, nt;
    int be, e;
    int l;
};
__device__ __forceinline__ int gswz(int r16) { return (0x78 >> (2 * ((r16 >> 2) & 3))) & 3; }
__device__ __forceinline__ void gemm_tile(const Params& p, const GemmJob& g, unsigned char* smem) {
    int tid_ = threadIdx.x; asm volatile("" : "+v"(tid_)); const int tid = tid_, lane = tid & 63, wave = __builtin_amdgcn_readfirstlane(tid >> 6);
    const int wr = wave >> 2, wc = wave & 3, fr = lane & 15, fq = lane >> 4;
    const int srow = lane >> 2;
    const int csrc = (lane & 3) ^ gswz(srow);
    const bf16_t* aptr[2]; const bf16_t* bptr[2];
    const int* IDX = WSP(int, WS_IDX);
#pragma unroll
    for (int i = 0; i < 2; ++i) {
        const int r = (i * 8 + wave) * 16 + srow;
        size_t arow;
        if (g.mode == G_MOE1) {
            const int wr_ = r >> 7, m = (r >> 4) & 7, f = r & 15;
            arow = (size_t)(m >> 2) * (D * D / 32) + g.nt * 128 + wr_ * 64 + (m & 3) * 16 + f;
            aptr[i] = g.B + arow * 32 + csrc * 8;
            continue;
        }
        else if (g.mode == G_MOE2) arow = (size_t)g.be * CAP + g.mt * 256 + r;
        else arow = (size_t)g.mt * 256 + r;
        aptr[i] = g.A + arow * 32 + csrc * 8;
    }
#pragma unroll
    for (int i = 0; i < 2; ++i) {
        const int r = (i * 8 + wave) * 16 + srow;
        size_t brow;
        if (g.mode == G_MOE1) {
            brow = (size_t)(g.be >> 4) * SEQ + IDX[(size_t)g.be * CAP + g.mt * 256 + r];
            bptr[i] = g.A + brow * 32 + csrc * 8;
            continue;
        }
        else { int c = g.nt * 256 + r; if (g.mode == G_PROJ && c >= INC) c = INC - 1; brow = c; }
        bptr[i] = g.B + brow * 32 + csrc * 8;
    }
    asm volatile("s_waitcnt lgkmcnt(0)" ::: "memory");
    __builtin_amdgcn_s_barrier();
    asm volatile("" ::: "memory");
    f32x4 acc[8][4];
#pragma unroll
    for (int m = 0; m < 8; ++m)
#pragma unroll
        for (int n = 0; n < 4; ++n) acc[m][n] = (f32x4){0.f, 0.f, 0.f, 0.f};
#define G_STAGE(buf, kt) do { _Pragma("unroll") for (int _i = 0; _i < 2; ++_i) \
        __builtin_amdgcn_global_load_lds((const unsigned*)(aptr[_i] + (size_t)(kt) * astep), (unsigned*)(smem + (buf) * 32768 + (_i * 8 + wave) * 1024), 16, 0, 0); \
        _Pragma("unroll") for (int _i = 0; _i < 2; ++_i) \
        __builtin_amdgcn_global_load_lds((const unsigned*)(bptr[_i] + (size_t)(kt) * bstep), (unsigned*)(smem + (buf) * 32768 + 16384 + (_i * 8 + wave) * 1024), 16, 0, 0); } while (0)
    const int bstep = __builtin_amdgcn_readfirstlane((g.mode == G_PROJ ? INC : g.mode == G_MOE1 ? NTOK : D) * 32);
    const int astep = __builtin_amdgcn_readfirstlane((g.mode == G_MOE2 ? 65536 : g.mode == G_MOE1 ? D : NTOK) * 32);
    G_STAGE(0, 0); G_STAGE(1, 1); G_STAGE(2, 2);
    const int coff = (fq ^ gswz(fr)) * 16;
    const int aoff = (wr * 128 + fr) * 64 + coff, boff = 16384 + (wc * 64 + fr) * 64 + coff;
#pragma unroll 1
    for (int t = 0; t < 32; ++t) {
        if (t < 30) asm volatile("s_waitcnt vmcnt(8)" ::: "memory"); else if (t == 30) asm volatile("s_waitcnt vmcnt(4)" ::: "memory"); else asm volatile("s_waitcnt vmcnt(0)" ::: "memory");
        __builtin_amdgcn_s_barrier();
        if (t + 3 < 32) G_STAGE((t + 3) & 3, t + 3);
        const unsigned char* sb = smem + (t & 3) * 32768;
        bf16x8 af[8], bfv[4];
#pragma unroll
        for (int n = 0; n < 4; ++n) bfv[n] = LDS_FRAG(sb, boff + n * 1024);
        af[0] = LDS_FRAG(sb, aoff); af[1] = LDS_FRAG(sb, aoff + 1024);
        __builtin_amdgcn_sched_barrier(0);
#pragma unroll
        for (int gq = 0; gq < 4; ++gq) {
            if (gq < 3) { af[2 * gq + 2] = LDS_FRAG(sb, aoff + (2 * gq + 2) * 1024); af[2 * gq + 3] = LDS_FRAG(sb, aoff + (2 * gq + 3) * 1024); }
            __builtin_amdgcn_sched_barrier(0);
#pragma unroll
            for (int mm = 0; mm < 2; ++mm)
#pragma unroll
                for (int n = 0; n < 4; ++n) acc[2 * gq + mm][n] = (g.mode == G_MOE1) ? MFMA16(af[2 * gq + mm], bfv[n], acc[2 * gq + mm][n]) : MFMA16(bfv[n], af[2 * gq + mm], acc[2 * gq + mm][n]);
            __builtin_amdgcn_sched_barrier(0);
        }
    }
#undef G_STAGE
    if (g.mode == G_PROJ) {
        bf16_t* PROJ = WSP(bf16_t, WS_PROJ);
        if (g.nt < 2) {
            const f32x2* ROT = WSP(f32x2, WS_ROT);
            const float ksc = (g.nt >= 1) ? 0.125f : 1.f;
#pragma unroll
            for (int m = 0; m < 8; ++m) {
                const size_t row = (size_t)g.mt * 256 + wr * 128 + m * 16 + fr;
#pragma unroll
                for (int n = 0; n < 2; ++n) {
                    const f32x4 cs0 = *(const f32x4*)(ROT + row * 32 + n * 16 + fq * 4), cs1 = *(const f32x4*)(ROT + row * 32 + n * 16 + fq * 4 + 2);
                    const float co[4] = {cs0.x, cs0.z, cs1.x, cs1.z}, si[4] = {cs0.y, cs0.w, cs1.y, cs1.w};
#pragma unroll
                    for (int r = 0; r < 4; ++r) {
                        const float x1 = acc[m][n][r], x2 = acc[m][n + 2][r];
                        acc[m][n][r] = (x1 * co[r] - x2 * si[r]) * ksc; acc[m][n + 2][r] = (x1 * si[r] + x2 * co[r]) * ksc;
                    }
                }
            }
        }
        if (g.nt * 256 + wc * 64 < PINC)
#pragma unroll
        for (int m = 0; m < 8; ++m) {
            const size_t row = (size_t)g.mt * 256 + wr * 128 + m * 16 + fr;
            bf16_t* orow = PROJ + row * PINC + g.nt * 256 + wc * 64 + swz8(fq);
#pragma unroll
            for (int n1 = 0; n1 < 2; ++n1) {
                u32x2 a, b;
                a.x = cvt_pk_bf16(acc[m][2 * n1][0], acc[m][2 * n1][1]); a.y = cvt_pk_bf16(acc[m][2 * n1][2], acc[m][2 * n1][3]);
                b.x = cvt_pk_bf16(acc[m][2 * n1 + 1][0], acc[m][2 * n1 + 1][1]); b.y = cvt_pk_bf16(acc[m][2 * n1 + 1][2], acc[m][2 * n1 + 1][3]);
                *(u32x4*)(orow + 32 * n1) = pair_swap16(a, b);
            }
        }
    } else if (g.mode == G_OUT) {
        const float* xin = (g.l == 0) ? p.in[0] : p.out;
#pragma unroll
        for (int m = 0; m < 8; ++m) {
            const size_t row = (size_t)g.mt * 256 + wr * 128 + m * 16 + fr;
#pragma unroll
            for (int n = 0; n < 4; ++n) {
                const int col = g.nt * 256 + wc * 64 + n * 16 + fq * 4;
                const f32x4 x = *(const f32x4*)(xin + row * D + col);
                *(f32x4*)(p.out + row * D + col) = x + acc[m][n];
            }
            __builtin_amdgcn_sched_barrier(0);
        }
    } else if (g.mode == G_MOE1) {
        bf16_t* HID = WSP(bf16_t, WS_HID);
#pragma unroll
        for (int n = 0; n < 4; ++n) {
            const size_t row = (size_t)g.be * CAP + g.mt * 256 + wc * 64 + n * 16 + fr;
#pragma unroll
            for (int q1 = 0; q1 < 2; ++q1) {
                u32x2 ab[2];
#pragma unroll
                for (int j = 0; j < 2; ++j) {
                    const int mq = 2 * q1 + j;
                    float h[4];
#pragma unroll
                    for (int r = 0; r < 4; ++r) h[r] = siluf_(acc[mq][n][r]) * acc[mq + 4][n][r];
                    ab[j].x = cvt_pk_bf16(h[0], h[1]); ab[j].y = cvt_pk_bf16(h[2], h[3]);
                }
                *(u32x4*)(HID + hid_off(row, g.nt * 128 + wr * 64 + 32 * q1 + swz8(fq))) = pair_swap16(ab[0], ab[1]);
            }
        }
    } else {
        bf16_t* OUTB = WSP(bf16_t, WS_OUTB);
        const float* GATE = WSP(float, WS_GATE);
#pragma unroll
        for (int m = 0; m < 8; ++m) {
            const int sl = g.mt * 256 + wr * 128 + m * 16 + fr;
            const float gt = GATE[(size_t)g.be * CAP + sl];
            const size_t row = (size_t)g.be * CAP + sl;
            bf16_t* orow = OUTB + row * D + g.nt * 256 + wc * 64 + swz8(fq);
#pragma unroll
            for (int n1 = 0; n1 < 2; ++n1) {
                u32x2 a, b;
                a.x = cvt_pk_bf16(acc[m][2 * n1][0] * gt, acc[m][2 * n1][1] * gt); a.y = cvt_pk_bf16(acc[m][2 * n1][2] * gt, acc[m][2 * n1][3] * gt);
                b.x = cvt_pk_bf16(acc[m][2 * n1 + 1][0] * gt, acc[m][2 * n1 + 1][1] * gt); b.y = cvt_pk_bf16(acc[m][2 * n1 + 1][2] * gt, acc[m][2 * n1 + 1][3] * gt);
                *(u32x4*)(orow + 32 * n1) = pair_swap16(a, b);
            }
        }
    }
}

__device__ __forceinline__ void phase_gemm(const Params& p, int mode, int l, unsigned char* smem) {
    const int bid = blockIdx.x, nb = gridDim.x;
    GemmJob g; g.mode = mode; g.l = l; g.be = 0; g.e = 0;
    if (mode == G_PROJ) {
        g.A = WSP(bf16_t, WS_HB); g.B = wt_in(p, l);
        if ((nb & 7) == 0) {
            const int xcd = bid & 7, j = bid >> 3, nj = nb >> 3;
            for (int q = j; q < 16 * 14; q += nj) { g.mt = (q / 14) * 8 + xcd; g.nt = q % 14; gemm_tile(p, g, smem); }
        } else
        for (int t = bid; t < 128 * 14; t += nb) { g.mt = t / 14; g.nt = t % 14; gemm_tile(p, g, smem); }
    } else if (mode == G_OUT) {
        g.A = WSP(bf16_t, WS_HB); g.B = wt_out(p, l);
        if ((nb & 7) == 0) {
            const int xcd = bid & 7, j = bid >> 3, nj = nb >> 3;
            for (int q = j; q < 16 * 4; q += nj) { g.mt = (q / 4) * 8 + xcd; g.nt = q % 4; gemm_tile(p, g, smem); }
        } else
        for (int t = bid; t < 128 * 4; t += nb) { g.mt = t / 4; g.nt = t % 4; gemm_tile(p, g, smem); }
    } else if (mode == G_MOE1) {
        for (int t = bid; t < 16 * 8 * 16; t += nb) {
            const int e = t >> 7, nt = (t >> 4) & 7, bm = t & 15, b = bm >> 1, mt = bm & 1;
            g.e = e; g.be = b * 16 + e; g.mt = mt; g.nt = nt;
            g.A = WSP(bf16_t, WS_HB); g.B = WSP(bf16_t, WS_WTEXP) + (size_t)(e * 3) * D * D;
            gemm_tile(p, g, smem);
        }
    } else {
        for (int t = bid; t < 16 * 4 * 16; t += nb) {
            const int e = t >> 6, nt = (t >> 4) & 3, bm = t & 15, b = bm >> 1, mt = bm & 1;
            g.e = e; g.be = b * 16 + e; g.mt = mt; g.nt = nt;
            g.A = WSP(bf16_t, WS_HID); g.B = WSP(bf16_t, WS_WTEXP) + (size_t)(e * 3 + 2) * D * D;
            gemm_tile(p, g, smem);
        }
    }
}

constexpr int P72 = 144;
constexpr int P40 = 80;
__device__ __forceinline__ void lds_st16(unsigned char* base, int off, float v) { *(bf16_t*)(base + off) = f2bf(v); }

__device__ __forceinline__ void ret_chain(const Params& p, int l, int b, int h, int dir, unsigned char* smem) {
    int tid_ = (threadIdx.x & 255); asm volatile("" : "+v"(tid_)); const int tid = tid_, lane = tid & 63, wave = tid >> 6, wr = wave >> 1, wc = wave & 1, fr = lane & 15, fq = lane >> 4;
    unsigned char* Qs = smem; unsigned char* Ks = smem + 9216; unsigned char* KtZ = smem + 18432; unsigned char* Vt = smem + 27648;
    unsigned char* Ps = smem + 36864; unsigned char* St = smem + 46080; float* stats = (float*)(smem + 55296);
    const bf16_t* PROJ = WSP(bf16_t, WS_PROJ);
    const f32x2* ROT = WSP(f32x2, WS_ROT);
    bf16_t* YF = dir ? WSP(bf16_t, WS_HB) : yt_buf(p, 0); constexpr int YCB = 0;
    const int li = tid >> 2, lp = tid & 3;
    {
        __syncthreads();
        const float lg2 = p.in[5][(l * 2 + dir) * 4 + h] * 1.4426950408889634f;
        const float cdec = exp2f(lg2 * 64.f);
        f32x4 sacc[2][2];
#pragma unroll
        for (int m = 0; m < 2; ++m)
#pragma unroll
            for (int n = 0; n < 2; ++n) sacc[m][n] = (f32x4){0.f, 0.f, 0.f, 0.f};
        for (int i = tid; i < 9216 / 4; i += NTHREADS) ((unsigned*)St)[i] = 0u;
        u32x4 q1, q2, k1, k2, v1, v2;
#define RET_LOAD(c) do { const int s_ = (c) * 64 + li; const size_t tok_ = (size_t)b * SEQ + (dir ? (SEQ - 1 - s_) : s_); const bf16_t* pr_ = PROJ + tok_ * PINC + h * 64 + 8 * lp; \
        q1 = *(const u32x4*)(pr_ + C_RQ); q2 = *(const u32x4*)(pr_ + C_RQ + 32); k1 = *(const u32x4*)(pr_ + C_RK); k2 = *(const u32x4*)(pr_ + C_RK + 32); \
        v1 = *(const u32x4*)(pr_ + C_RV); v2 = *(const u32x4*)(pr_ + C_RV + 32); } while (0)
        RET_LOAD(0);
#pragma unroll 1
        for (int c = 0; c < 64; ++c) {
            __syncthreads();
            {
                *(u32x4*)(Qs + li * P72 + 16 * lp) = q1; *(u32x4*)(Qs + li * P72 + 64 + 16 * lp) = q2;
                *(u32x4*)(Ks + li * P72 + 16 * lp) = k1; *(u32x4*)(Ks + li * P72 + 64 + 16 * lp) = k2;
                const float zeta = exp2f(lg2 * (float)(63 - li));
                float ka[8], kb[8];
                unpack8(k1, ka); unpack8(k2, kb);
#pragma unroll
                for (int j = 0; j < 8; ++j) { lds_st16(KtZ, (8 * lp + j) * P72 + li * 2, ka[j] * zeta); lds_st16(KtZ, (32 + 8 * lp + j) * P72 + li * 2, kb[j] * zeta); }
                const unsigned vw[8] = {v1.x, v1.y, v1.z, v1.w, v2.x, v2.y, v2.z, v2.w};
#pragma unroll
                for (int j = 0; j < 4; ++j) {
                    *(bf16_t*)(Vt + (8 * lp + 2 * j) * P72 + li * 2) = (bf16_t)(vw[j] & 0xffffu); *(bf16_t*)(Vt + (8 * lp + 2 * j + 1) * P72 + li * 2) = (bf16_t)(vw[j] >> 16);
                    *(bf16_t*)(Vt + (32 + 8 * lp + 2 * j) * P72 + li * 2) = (bf16_t)(vw[4 + j] & 0xffffu); *(bf16_t*)(Vt + (32 + 8 * lp + 2 * j + 1) * P72 + li * 2) = (bf16_t)(vw[4 + j] >> 16);
                }
            }
            __syncthreads();
            f32x4 yc[2][2];
            {
                f32x4 sc[2][2];
#pragma unroll
                for (int m = 0; m < 2; ++m)
#pragma unroll
                    for (int n = 0; n < 2; ++n) { sc[m][n] = (f32x4){0.f, 0.f, 0.f, 0.f}; yc[m][n] = (f32x4){0.f, 0.f, 0.f, 0.f}; }
#pragma unroll
                for (int kk = 0; kk < 2; ++kk) {
                    bf16x8 qf[2], kf[2], sf[2];
#pragma unroll
                    for (int m = 0; m < 2; ++m) qf[m] = LDS_FRAG(Qs, (32 * wr + 16 * m + fr) * P72 + (32 * kk + 8 * fq) * 2);
#pragma unroll
                    for (int n = 0; n < 2; ++n) { kf[n] = LDS_FRAG(Ks, (32 * wc + 16 * n + fr) * P72 + (32 * kk + 8 * fq) * 2); sf[n] = LDS_FRAG(St, (32 * wc + 16 * n + fr) * P72 + (32 * kk + 8 * fq) * 2); }
#pragma unroll
                    for (int m = 0; m < 2; ++m)
#pragma unroll
                        for (int n = 0; n < 2; ++n) { sc[m][n] = MFMA16(kf[n], qf[m], sc[m][n]); yc[m][n] = MFMA16(sf[n], qf[m], yc[m][n]); }
                    __builtin_amdgcn_sched_barrier(0);
                }
#pragma unroll
                for (int m = 0; m < 2; ++m)
#pragma unroll
                    for (int n = 0; n < 2; ++n) {
                        const int i = 32 * wr + 16 * m + fr, j0 = 32 * wc + 16 * n + 4 * fq;
                        float pv[4];
#pragma unroll
                        for (int r = 0; r < 4; ++r) { const int dlt = i - (j0 + r); pv[r] = (dlt >= 0) ? sc[m][n][r] * exp2f(lg2 * (float)dlt) : 0.f; }
                        u32x2 o; o.x = cvt_pk_bf16(pv[0], pv[1]); o.y = cvt_pk_bf16(pv[2], pv[3]);
                        *(u32x2*)(Ps + i * P72 + j0 * 2) = o;
                    }
            }
            __syncthreads();
            if (c + 1 < 64) RET_LOAD(c + 1);
            f32x4 y[2][2];
#pragma unroll
            for (int m = 0; m < 2; ++m)
#pragma unroll
                for (int n = 0; n < 2; ++n) { y[m][n] = (f32x4){0.f, 0.f, 0.f, 0.f}; sacc[m][n] = sacc[m][n] * cdec; }
#pragma unroll
            for (int kk = 0; kk < 2; ++kk) {
                bf16x8 pf[2], vf[2], zf[2];
#pragma unroll
                for (int m = 0; m < 2; ++m) { pf[m] = LDS_FRAG(Ps, (32 * wr + 16 * m + fr) * P72 + (32 * kk + 8 * fq) * 2); zf[m] = LDS_FRAG(KtZ, (32 * wr + 16 * m + fr) * P72 + (32 * kk + 8 * fq) * 2); }
#pragma unroll
                for (int n = 0; n < 2; ++n) vf[n] = LDS_FRAG(Vt, (32 * wc + 16 * n + fr) * P72 + (32 * kk + 8 * fq) * 2);
#pragma unroll
                for (int m = 0; m < 2; ++m)
#pragma unroll
                    for (int n = 0; n < 2; ++n) { y[m][n] = MFMA16(vf[n], pf[m], y[m][n]); sacc[m][n] = MFMA16(zf[m], vf[n], sacc[m][n]); }
                __builtin_amdgcn_sched_barrier(0);
            }
#pragma unroll
            for (int m = 0; m < 2; ++m)
#pragma unroll
                for (int n = 0; n < 2; ++n) {
                    u32x2 o; o.x = cvt_pk_bf16(sacc[m][n][0], sacc[m][n][1]); o.y = cvt_pk_bf16(sacc[m][n][2], sacc[m][n][3]);
                    *(u32x2*)(St + (32 * wc + 16 * n + fr) * P72 + (32 * wr + 16 * m + 4 * fq) * 2) = o;
                }
            {
#pragma unroll
                for (int m = 0; m < 2; ++m) {
                    const int i = 32 * wr + 16 * m + fr; const float xi = exp2f(lg2 * (float)(i + 1));
                    const int s = c * 64 + i; const size_t tok = (size_t)b * SEQ + (dir ? (SEQ - 1 - s) : s);
#pragma unroll
                    for (int n = 0; n < 2; ++n) {
                        const f32x4 yy = y[m][n] + yc[m][n] * xi;
                        u32x2 o; o.x = cvt_pk_bf16(yy[0], yy[1]); o.y = cvt_pk_bf16(yy[2], yy[3]);
                        { const int yc_ = h * 64 + 32 * wc + 16 * n + 4 * fq; *(u32x2*)(YF + (dir ? hb_off(tok, YCB + yc_) : tok * 256 + yc_)) = o; }
                    }
                }
            }
        }
#undef RET_LOAD
        __syncthreads();
    }
}

__device__ __forceinline__ void gla_chain(const Params& p, int l, int b, int h, int dir, unsigned char* smem) {
    int tid_ = (threadIdx.x & 255); asm volatile("" : "+v"(tid_)); const int tid = tid_, lane = tid & 63, wave = tid >> 6, wr = wave >> 1, wc = wave & 1, fr = lane & 15, fq = lane >> 4;
    unsigned char* Qd = smem; unsigned char* Kd = smem + 5120; unsigned char* KeT = smem + 10240; unsigned char* Vt = smem + 14848;
    unsigned char* Ps = smem + 24064; unsigned char* St = smem + 33280;
    float* bcum = (float*)(smem + 38400);
    float* gsum = (float*)(smem + 46592);
    float* xas = (float*)(smem + 47616);
    float* stats = (float*)(smem + 51712);
    const bf16_t* PROJ = WSP(bf16_t, WS_PROJ);
    bf16_t* YF = dir ? WSP(bf16_t, WS_HB) : yt_buf(p, 1); constexpr int YCB = 768;
    const int li = tid >> 2, lc = tid & 3;
    const int ck = tid & 31, cg = tid >> 5;
    {
        __syncthreads();
        float au[16];
#pragma unroll
        for (int r = 0; r < 16; ++r) au[r] = p.in[24][((size_t)(l * 2 + dir) * 16 + r) * 128 + h * 32 + ck];
        const float ab = p.in[25][(l * 2 + dir) * 128 + h * 32 + ck];
        f32x4 sacc[2];
        sacc[0] = (f32x4){0.f, 0.f, 0.f, 0.f}; sacc[1] = (f32x4){0.f, 0.f, 0.f, 0.f};
        for (int i = tid; i < 5120 / 4; i += NTHREADS) ((unsigned*)St)[i] = 0u;
#pragma unroll 1
        for (int c = 0; c < 64; ++c) {
            __syncthreads();
            if (tid < 128) {
                const int i = tid >> 1, hf = tid & 1; const int s = c * 64 + i; const size_t tok = (size_t)b * SEQ + (dir ? (SEQ - 1 - s) : s);
                const u32x4 xv = *(const u32x4*)(PROJ + tok * PINC + C_GXA + 8 * hf);
                float f[8]; unpack8(xv, f);
#pragma unroll
                for (int j = 0; j < 8; ++j) xas[i * 16 + 8 * hf + j] = f[j];
            }
            const int s3 = c * 64 + li; const size_t tok3 = (size_t)b * SEQ + (dir ? (SEQ - 1 - s3) : s3);
            const u32x4 qv = *(const u32x4*)(PROJ + tok3 * PINC + C_GQ + h * 32 + 8 * lc);
            const u32x4 kv = *(const u32x4*)(PROJ + tok3 * PINC + C_GK + h * 32 + 8 * lc);
            const u32x4 va = *(const u32x4*)(PROJ + tok3 * PINC + C_GV + h * 64 + 16 * lc);
            const u32x4 vb = *(const u32x4*)(PROJ + tok3 * PINC + C_GV + h * 64 + 16 * lc + 8);
            __syncthreads();
            float loc[8];
            {
                float run = 0.f;
#pragma unroll
                for (int ii = 0; ii < 8; ++ii) {
                    const int i = 8 * cg + ii; float z = ab;
#pragma unroll
                    for (int r = 0; r < 16; ++r) z += xas[i * 16 + r] * au[r];
                    const float la = -softplusf_(-z) * (1.f / 16.f);
                    run += la; loc[ii] = run;
                }
                gsum[cg * 32 + ck] = run;
            }
            __syncthreads();
            {
                float off = 0.f;
#pragma unroll
                for (int g2 = 0; g2 < 8; ++g2) off += (g2 < cg) ? gsum[g2 * 32 + ck] : 0.f;
#pragma unroll
                for (int ii = 0; ii < 8; ++ii) bcum[(8 * cg + ii) * 32 + ck] = loc[ii] + off;
            }
            __syncthreads();
            {
                float qf[8], kf[8], v16[16], qd[8], kd[8];
                unpack8(qv, qf); unpack8(kv, kf); unpack8(va, v16); unpack8(vb, v16 + 8);
#pragma unroll
                for (int j = 0; j < 8; ++j) {
                    const float bc = bcum[li * 32 + 8 * lc + j], bl = bcum[63 * 32 + 8 * lc + j];
                    qd[j] = qf[j] * __expf(bc) * 0.17677669529663687f; kd[j] = kf[j] * __expf(-bc);
                    lds_st16(KeT, (8 * lc + j) * P72 + li * 2, kf[j] * __expf(bl - bc));
                }
                *(u32x4*)(Qd + li * P40 + 16 * lc) = pack8(qd); *(u32x4*)(Kd + li * P40 + 16 * lc) = pack8(kd);
#pragma unroll
                for (int j = 0; j < 16; ++j) lds_st16(Vt, (16 * lc + j) * P72 + li * 2, v16[j]);
            }
            __syncthreads();
            f32x4 yc[2][2];
            {
                f32x4 sc[2][2];
                bf16x8 qfr[2], kfr[2], sfr[2];
#pragma unroll
                for (int m = 0; m < 2; ++m) qfr[m] = LDS_FRAG(Qd, (32 * wr + 16 * m + fr) * P40 + 16 * fq);
#pragma unroll
                for (int n = 0; n < 2; ++n) { kfr[n] = LDS_FRAG(Kd, (32 * wc + 16 * n + fr) * P40 + 16 * fq); sfr[n] = LDS_FRAG(St, (32 * wc + 16 * n + fr) * P40 + 16 * fq); }
#pragma unroll
                for (int m = 0; m < 2; ++m)
#pragma unroll
                    for (int n = 0; n < 2; ++n) {
                        sc[m][n] = MFMA16(kfr[n], qfr[m], ((f32x4){0.f, 0.f, 0.f, 0.f})); yc[m][n] = MFMA16(sfr[n], qfr[m], ((f32x4){0.f, 0.f, 0.f, 0.f}));
                        const int i = 32 * wr + 16 * m + fr, j0 = 32 * wc + 16 * n + 4 * fq;
                        float pv[4];
#pragma unroll
                        for (int r = 0; r < 4; ++r) pv[r] = (i >= j0 + r) ? sc[m][n][r] : 0.f;
                        u32x2 o; o.x = cvt_pk_bf16(pv[0], pv[1]); o.y = cvt_pk_bf16(pv[2], pv[3]);
                        *(u32x2*)(Ps + i * P72 + j0 * 2) = o;
                    }
            }
            __syncthreads();
            f32x4 y[2][2];
#pragma unroll
            for (int m = 0; m < 2; ++m)
#pragma unroll
                for (int n = 0; n < 2; ++n) y[m][n] = yc[m][n];
            {
                float dk[4];
#pragma unroll
                for (int r = 0; r < 4; ++r) dk[r] = __expf(bcum[63 * 32 + 16 * wr + 4 * fq + r]);
#pragma unroll
                for (int n = 0; n < 2; ++n)
#pragma unroll
                    for (int r = 0; r < 4; ++r) sacc[n][r] *= dk[r];
            }
#pragma unroll
            for (int kk = 0; kk < 2; ++kk) {
                bf16x8 pf[2], vf[2];
#pragma unroll
                for (int m = 0; m < 2; ++m) pf[m] = LDS_FRAG(Ps, (32 * wr + 16 * m + fr) * P72 + (32 * kk + 8 * fq) * 2);
#pragma unroll
                for (int n = 0; n < 2; ++n) vf[n] = LDS_FRAG(Vt, (32 * wc + 16 * n + fr) * P72 + (32 * kk + 8 * fq) * 2);
                const bf16x8 kef = LDS_FRAG(KeT, (16 * wr + fr) * P72 + (32 * kk + 8 * fq) * 2);
#pragma unroll
                for (int m = 0; m < 2; ++m)
#pragma unroll
                    for (int n = 0; n < 2; ++n) y[m][n] = MFMA16(vf[n], pf[m], y[m][n]);
#pragma unroll
                for (int n = 0; n < 2; ++n) sacc[n] = MFMA16(kef, vf[n], sacc[n]);
            }
#pragma unroll
            for (int n = 0; n < 2; ++n) {
                u32x2 o; o.x = cvt_pk_bf16(sacc[n][0], sacc[n][1]); o.y = cvt_pk_bf16(sacc[n][2], sacc[n][3]);
                *(u32x2*)(St + (32 * wc + 16 * n + fr) * P40 + (16 * wr + 4 * fq) * 2) = o;
            }
            {
#pragma unroll
                for (int m = 0; m < 2; ++m) {
                    const int i = 32 * wr + 16 * m + fr; const int s = c * 64 + i; const size_t tok = (size_t)b * SEQ + (dir ? (SEQ - 1 - s) : s);
#pragma unroll
                    for (int n = 0; n < 2; ++n) {
                        u32x2 o; o.x = cvt_pk_bf16(y[m][n][0], y[m][n][1]); o.y = cvt_pk_bf16(y[m][n][2], y[m][n][3]);
                        { const int yc_ = h * 64 + 32 * wc + 16 * n + 4 * fq; *(u32x2*)(YF + (dir ? hb_off(tok, YCB + yc_) : tok * 256 + yc_)) = o; }
                    }
                }
            }
        }
        __syncthreads();
    }
}

__device__ __forceinline__ void lru_chain(const Params& p, int l, int b, int hd, int dir, unsigned char* smem) {
    int tid_ = (threadIdx.x & 255); asm volatile("" : "+v"(tid_)); const int tid = tid_, lane = tid & 63, wave = tid >> 6, wr = wave >> 1, wc = wave & 1, fr = lane & 15, fq = lane >> 4;
    unsigned char* W0t = smem; unsigned char* W1t = smem + 9216; unsigned char* Xc = smem + 18432;
    float* Aa = (float*)(smem + 27648); float* Bx = (float*)(smem + 44032);
    const bf16_t* PROJ = WSP(bf16_t, WS_PROJ);
    bf16_t* YF = dir ? WSP(bf16_t, WS_HB) : yt_buf(p, 2); constexpr int YCB = 512;
    const bf16_t* sw = wt_small(p, l) + SW_LRU;
    const int li = tid >> 2, lc = tid & 3;
    float* CW = (float*)(smem + 60416);
    __syncthreads();
    for (int i = tid; i < 320; i += NTHREADS) CW[i] = (i < 256) ? p.in[19][(size_t)l * 1024 + (i >> 6) * 256 + hd * 64 + (i & 63)] : p.in[20][(size_t)l * 256 + hd * 64 + (i & 63)];
    const float* cw = CW + 16 * lc;
    {
        __syncthreads();
        for (int i = tid; i < 2 * 64 * 8; i += NTHREADS) {
            const int g = i >> 9, r = (i >> 3) & 63, ch = i & 7;
            const u32x4 v = *(const u32x4*)(sw + ((size_t)((dir * 2 + g) * 4 + hd)) * 4096 + r * 64 + ch * 8);
            *(u32x4*)((g ? W1t : W0t) + r * P72 + ch * 16) = v;
        }
        float sp8[2][4], b0[2][4], b1[2][4];
#pragma unroll
        for (int n = 0; n < 2; ++n)
#pragma unroll
            for (int r = 0; r < 4; ++r) {
                const int e = hd * 64 + 32 * wc + 16 * n + 4 * fq + r;
                sp8[n][r] = 8.f * softplusf_(-p.in[23][(l * 2 + dir) * 256 + e]);
                b0[n][r] = p.in[22][((l * 2 + dir) * 2 + 0) * 256 + e]; b1[n][r] = p.in[22][((l * 2 + dir) * 2 + 1) * 256 + e];
            }
        float hcar = 0.f;
        u32x4 lxa[4], lxb[4];
#define LRU_LOAD(c) do { const int s_ = (c) * 64 + li; const int t_ = dir ? (SEQ - 1 - s_) : s_; \
            _Pragma("unroll") for (int tap = 0; tap < 4; ++tap) { const int tt = t_ + tap - 2; lxa[tap] = (u32x4){0u, 0u, 0u, 0u}; lxb[tap] = (u32x4){0u, 0u, 0u, 0u}; \
                if (tt >= 0 && tt < SEQ) { const bf16_t* src_ = PROJ + ((size_t)b * SEQ + tt) * PINC + C_LX + hd * 64 + 16 * lc; lxa[tap] = *(const u32x4*)src_; lxb[tap] = *(const u32x4*)(src_ + 8); } } } while (0)
        LRU_LOAD(0);
#pragma unroll 1
        for (int c = 0; c < 64; ++c) {
            {
                float xc[16];
#pragma unroll
                for (int j = 0; j < 16; ++j) xc[j] = cw[256 + j];
#pragma unroll
                for (int tap = 0; tap < 4; ++tap) {
                    float f[16]; unpack8(lxa[tap], f); unpack8(lxb[tap], f + 8);
#pragma unroll
                    for (int j = 0; j < 16; ++j) xc[j] += f[j] * cw[tap * 64 + j];
                }
                *(u32x4*)(Xc + li * P72 + 32 * lc) = pack8(xc); *(u32x4*)(Xc + li * P72 + 32 * lc + 16) = pack8(xc + 8);
            }
            __syncthreads();
            if (c + 1 < 64) LRU_LOAD(c + 1);
            {
                f32x4 g0[2][2], g1[2][2];
#pragma unroll
                for (int m = 0; m < 2; ++m)
#pragma unroll
                    for (int n = 0; n < 2; ++n) { g0[m][n] = (f32x4){0.f, 0.f, 0.f, 0.f}; g1[m][n] = (f32x4){0.f, 0.f, 0.f, 0.f}; }
#pragma unroll
                for (int kk = 0; kk < 2; ++kk) {
                    bf16x8 xf[2], w0f[2], w1f[2];
#pragma unroll
                    for (int m = 0; m < 2; ++m) xf[m] = LDS_FRAG(Xc, (32 * wr + 16 * m + fr) * P72 + (32 * kk + 8 * fq) * 2);
#pragma unroll
                    for (int n = 0; n < 2; ++n) { w0f[n] = LDS_FRAG(W0t, (32 * wc + 16 * n + fr) * P72 + (32 * kk + 8 * fq) * 2); w1f[n] = LDS_FRAG(W1t, (32 * wc + 16 * n + fr) * P72 + (32 * kk + 8 * fq) * 2); }
#pragma unroll
                    for (int m = 0; m < 2; ++m)
#pragma unroll
                        for (int n = 0; n < 2; ++n) { g0[m][n] = MFMA16(w0f[n], xf[m], g0[m][n]); g1[m][n] = MFMA16(w1f[n], xf[m], g1[m][n]); }
                }
#pragma unroll
                for (int m = 0; m < 2; ++m)
#pragma unroll
                    for (int n = 0; n < 2; ++n) {
                        const int i = 32 * wr + 16 * m + fr, e0 = 32 * wc + 16 * n + 4 * fq;
                        const u32x2 xv = *(const u32x2*)(Xc + i * P72 + e0 * 2);
                        const float x4[4] = {bf_lo(xv.x), bf_hi(xv.x), bf_lo(xv.y), bf_hi(xv.y)};
                        f32x4 av, bv;
#pragma unroll
                        for (int r = 0; r < 4; ++r) {
                            const float la = -sp8[n][r] * sigmoidf_(g0[m][n][r] + b0[n][r]);
                            av[r] = __expf(la);
                            const float x2 = 2.f * la;
                            const float em = (x2 > -0.25f) ? -x2 * (1.f + x2 * (0.5f + x2 * (0.16666667f + x2 * (0.041666668f + x2 * (0.0083333338f + x2 * 0.0013888889f))))) : 1.f - __expf(x2);
                            bv[r] = __builtin_amdgcn_sqrtf(em) * sigmoidf_(g1[m][n][r] + b1[n][r]) * x4[r];
                        }
                        *(f32x4*)(Aa + i * 64 + e0) = av; *(f32x4*)(Bx + i * 64 + e0) = bv;
                    }
            }
            __syncthreads();
            if (wave == 0) {
#pragma unroll 8
                for (int i = 0; i < 64; ++i) { hcar = Aa[i * 64 + lane] * hcar + Bx[i * 64 + lane]; Bx[i * 64 + lane] = hcar; }
            }
            __syncthreads();
            {
                const int s = c * 64 + li; const int t = dir ? (SEQ - 1 - s) : s; const size_t tok = (size_t)b * SEQ + t;
                float hv[16];
#pragma unroll
                for (int j = 0; j < 4; ++j) { const f32x4 v = *(const f32x4*)(Bx + li * 64 + 16 * lc + 4 * j); hv[4 * j] = v.x; hv[4 * j + 1] = v.y; hv[4 * j + 2] = v.z; hv[4 * j + 3] = v.w; }
                bf16_t* yo_ = YF + (dir ? hb_off(tok, YCB + hd * 64 + 16 * lc) : tok * 256 + hd * 64 + 16 * lc);
                *(u32x4*)yo_ = pack8(hv); *(u32x4*)(yo_ + 8) = pack8(hv + 8);
            }
        }
#undef LRU_LOAD
    }
    __syncthreads();
}

__device__ __forceinline__ void rwkv_prepass_item(const Params& p, int l, int item, unsigned char* smem) {
    int tid_ = (threadIdx.x & 255); asm volatile("" : "+v"(tid_)); const int tid = tid_, lane = tid & 63, wave = tid >> 6, fr = lane & 15, fq = lane >> 4;
    constexpr int PA = 528;
    unsigned char* XW = smem; unsigned char* XA = smem + 9216; unsigned char* AL = smem + 18432;
    const bf16_t* PROJ = WSP(bf16_t, WS_PROJ);
    const bf16_t* sw = wt_small(p, l);
    const int dir = item & 1; const size_t tok0 = (size_t)(item >> 1) * 64; const int t0 = (int)(tok0 & (SEQ - 1));
    bf16_t* WA = WSP(bf16_t, WS_WA) + (size_t)dir * NTOK * 512;
    float* SC = WSP(float, WS_SC) + (size_t)dir * NTOK * 16;
    const int li = tid >> 2, lc = tid & 3;
    const int t = t0 + li; const size_t tok = tok0 + li;
    const bool hp = dir ? (t < SEQ - 1) : (t > 0);
    const bf16_t* pc = PROJ + tok * PINC; const bf16_t* pp = dir ? pc + PINC : pc - PINC;
    __syncthreads();
    {
        const u32x4 z = {0u, 0u, 0u, 0u};
#pragma unroll
        for (int hf = 0; hf < 2; ++hf) {
            const u32x4 wc_ = *(const u32x4*)(pc + C_WXW + 16 * lc + 8 * hf), wp_ = hp ? *(const u32x4*)(pp + C_WXW + 16 * lc + 8 * hf) : z;
            const u32x4 ac_ = *(const u32x4*)(pc + C_WXA + 16 * lc + 8 * hf), ap_ = hp ? *(const u32x4*)(pp + C_WXA + 16 * lc + 8 * hf) : z;
            float a[8], bq[8], o[8];
            unpack8(wc_, a); unpack8(wp_, bq);
#pragma unroll
            for (int j = 0; j < 8; ++j) o[j] = tanhf_(a[j] + p.in[8][l * 64 + 16 * lc + 8 * hf + j] * (bq[j] - a[j]));
            *(u32x4*)(XW + li * P72 + 32 * lc + 16 * hf) = pack8(o);
            unpack8(ac_, a); unpack8(ap_, bq);
#pragma unroll
            for (int j = 0; j < 8; ++j) o[j] = a[j] + p.in[9][l * 64 + 16 * lc + 8 * hf + j] * (bq[j] - a[j]);
            *(u32x4*)(XA + li * P72 + 32 * lc + 16 * hf) = pack8(o);
        }
    }
    __syncthreads();
#pragma unroll
    for (int which = 0; which < 2; ++which) {
        f32x4 acc[4][4];
#pragma unroll
        for (int m = 0; m < 4; ++m)
#pragma unroll
            for (int n = 0; n < 4; ++n) acc[m][n] = (f32x4){0.f, 0.f, 0.f, 0.f};
        const unsigned char* XS = which ? XA : XW;
        const bf16_t* wsrc = sw + (which ? SW_AUP : SW_WUP) + dir * 16384;
#pragma unroll
        for (int kk = 0; kk < 2; ++kk) {
            bf16x8 xf[4];
#pragma unroll
            for (int m = 0; m < 4; ++m) xf[m] = LDS_FRAG(XS, (16 * m + fr) * P72 + (32 * kk + 8 * fq) * 2);
#pragma unroll
            for (int n = 0; n < 4; ++n) {
                const bf16x8 bw = *(const bf16x8*)(wsrc + (64 * wave + 16 * n + fr) * 64 + 32 * kk + 8 * fq);
#pragma unroll
                for (int m = 0; m < 4; ++m) acc[m][n] = MFMA16(bw, xf[m], acc[m][n]);
            }
        }
#pragma unroll
        for (int n1 = 0; n1 < 2; ++n1) {
            const f32x4 c0a = *(const f32x4*)(p.in[which ? 12 : 10] + (l * 2 + dir) * 256 + 64 * wave + 32 * n1 + 4 * fq);
            const f32x4 c0b = *(const f32x4*)(p.in[which ? 12 : 10] + (l * 2 + dir) * 256 + 64 * wave + 32 * n1 + 16 + 4 * fq);
            const int colw = 64 * wave + 32 * n1 + swz8(fq);
#pragma unroll
            for (int m = 0; m < 4; ++m) {
                float oa[4], ob[4];
#pragma unroll
                for (int r = 0; r < 4; ++r) {
                    const float sa = sigmoidf_(c0a[r] + acc[m][2 * n1][r]), sb = sigmoidf_(c0b[r] + acc[m][2 * n1 + 1][r]);
                    oa[r] = which ? sa : -0.8750387749f * sa; ob[r] = which ? sb : -0.8750387749f * sb;
                }
                u32x2 a, b; a.x = cvt_pk_bf16(oa[0], oa[1]); a.y = cvt_pk_bf16(oa[2], oa[3]); b.x = cvt_pk_bf16(ob[0], ob[1]); b.y = cvt_pk_bf16(ob[2], ob[3]);
                const u32x4 o = pair_swap16(a, b);
                *(u32x4*)(WA + (tok0 + 16 * m + fr) * 512 + which * 256 + colw) = o;
                if (which) *(u32x4*)(AL + (16 * m + fr) * PA + colw * 2) = o;
            }
        }
        __builtin_amdgcn_sched_barrier(0);
    }
    __syncthreads();
    {
        const int col = (tid & 31) * 8;
        float muk[8], mur[8], kkq[8], kaq[8], bnq[8];
        {
            const f32x4 a0 = *(const f32x4*)(p.in[7] + (size_t)l * 768 + 256 + col), a1 = *(const f32x4*)(p.in[7] + (size_t)l * 768 + 256 + col + 4);
            const f32x4 b0 = *(const f32x4*)(p.in[7] + (size_t)l * 768 + col), b1 = *(const f32x4*)(p.in[7] + (size_t)l * 768 + col + 4);
            const f32x4 c0 = *(const f32x4*)(p.in[15] + l * 256 + col), c1 = *(const f32x4*)(p.in[15] + l * 256 + col + 4);
            const f32x4 d0 = *(const f32x4*)(p.in[16] + l * 256 + col), d1 = *(const f32x4*)(p.in[16] + l * 256 + col + 4);
            const f32x4 e0 = *(const f32x4*)(p.in[17] + l * 256 + col), e1 = *(const f32x4*)(p.in[17] + l * 256 + col + 4);
#pragma unroll
            for (int j = 0; j < 4; ++j) { muk[j] = a0[j]; muk[4 + j] = a1[j]; mur[j] = b0[j]; mur[4 + j] = b1[j]; kkq[j] = c0[j]; kkq[4 + j] = c1[j]; kaq[j] = d0[j]; kaq[4 + j] = d1[j]; bnq[j] = e0[j]; bnq[4 + j] = e1[j]; }
        }
        const u32x4 z = {0u, 0u, 0u, 0u};
#pragma unroll 2
        for (int rr = 0; rr < 8; ++rr) {
            const int lt = rr * 8 + (tid >> 5);
            const int tt = t0 + lt; const size_t tk = tok0 + lt;
            const bool hq = dir ? (tt < SEQ - 1) : (tt > 0);
            const bf16_t* qc = PROJ + tk * PINC; const bf16_t* qp = dir ? qc + PINC : qc - PINC;
            const u32x4 kc_ = *(const u32x4*)(qc + C_WK + col), kp_ = hq ? *(const u32x4*)(qp + C_WK + col) : z;
            const u32x4 rc_ = *(const u32x4*)(qc + C_WR + col), rp_ = hq ? *(const u32x4*)(qp + C_WR + col) : z;
            const u32x4 al_ = *(const u32x4*)(AL + lt * PA + col * 2);
            float kc[8], kp[8], rc[8], rp[8], av[8];
            unpack8(kc_, kc); unpack8(kp_, kp); unpack8(rc_, rc); unpack8(rp_, rp); unpack8(al_, av);
            float ss = 0.f, u1 = 0.f, c2 = 0.f, bon = 0.f;
#pragma unroll
            for (int j = 0; j < 8; ++j) {
                const float ks = kc[j] + muk[j] * (kp[j] - kc[j]);
                const float rs = rc[j] + mur[j] * (rp[j] - rc[j]);
                const float kk = ks * kkq[j];
                const float km = ks * (1.f + (av[j] - 1.f) * kaq[j]);
                ss += kk * kk; u1 += kk * av[j] * rs; c2 += km * rs; bon += rs * km * bnq[j];
            }
            ss += dpp_xor1(ss); u1 += dpp_xor1(u1); c2 += dpp_xor1(c2); bon += dpp_xor1(bon);
            ss += dpp_xor2(ss); u1 += dpp_xor2(u1); c2 += dpp_xor2(c2); bon += dpp_xor2(bon);
            ss += dpp_hmirror(ss); u1 += dpp_hmirror(u1); c2 += dpp_hmirror(c2); bon += dpp_hmirror(bon);
            const float inv = 1.f / fmaxf(sqrtf(ss), 1e-12f);
            if ((tid & 7) == 0) *(f32x4*)(SC + (tk * 4 + (col >> 6)) * 4) = (f32x4){inv, inv * u1, c2, bon};
        }
    }
}
__device__ __forceinline__ void phase_rwkv_prepass(const Params& p, int l, unsigned char* smem) {
    constexpr int NIT = (NTOK / 64) * 2;
    for (int k = 0; k < (NIT + NVB_ - 1) / NVB_; ++k) {
        const int it = VBID_ + k * NVB_;
        rwkv_prepass_item(p, l, it < NIT ? it : NIT - 1, smem);
    }
}

constexpr int RW_AR = 0, RW_BK = 18432, RW_UT = 27648, RW_WT = 55296, RW_MM = 82944, RW_LK = 92160, RW_LB = 97280, RW_PC = 105472, RW_CUM = 106496, RW_S0 = 114688, RW_RH = 123904;
static_assert(RW_RH + 8192 <= 2 * LDS_MAIN, "rwkv LDS layout");
__device__ __forceinline__ void rwkv_chain(const Params& p, int l, int b, int h, int dir, unsigned char* smem) {
    int tid_ = (threadIdx.x & 255); asm volatile("" : "+v"(tid_)); const int tid = tid_, lane = tid & 63, wave = tid >> 6, wr = wave >> 1, wc = wave & 1, fr = lane & 15, fq = lane >> 4;
    const int vb = VB_;
    unsigned char* BK = smem + RW_BK; unsigned char* S0b = smem + RW_S0;
    float* RH = (float*)(smem + RW_RH);
    float* CUM = (float*)(smem + RW_CUM);
    const bf16_t* PROJ = WSP(bf16_t, WS_PROJ);
    bf16_t* YO = WSP(bf16_t, WS_YRW + (size_t)dir * 16 * MiB);
    const bf16_t* WA = WSP(bf16_t, WS_WA) + (size_t)dir * NTOK * 512;
    const float* SC = WSP(float, WS_SC) + (size_t)dir * NTOK * 16;
#define RW_BUF_AR(j) (smem + RW_AR + ((j) & 1) * 9216)
#define RW_BUF_UT(j) (smem + RW_UT + ((j) % 3) * 9216)
#define RW_BUF_WT(j) (smem + RW_WT + ((j) % 3) * 9216)
#define RW_BUF_PC(j) ((float*)(smem + RW_PC + ((j) % 3) * 256))
#define RW_BUF_MM(j) (smem + RW_MM + ((j) & 1) * 4608)
#define RW_BUF_LK(j) (smem + RW_LK + ((j) & 1) * 2560)
#define RW_BUF_LB(j) ((float*)(smem + RW_LB + ((j) & 1) * 4096))
    if (vb == 0) for (int i = tid; i < 9216 / 4; i += NTHREADS) ((unsigned*)S0b)[i] = 0u;
    __syncthreads();
    if (vb == 1) {
        __builtin_amdgcn_s_setprio(2);
        const int pi = tid >> 3, pg = tid & 7;
        float mu[3][8], kkp[8], kap[8];
        {
            const float* mu_ = p.in[7] + (size_t)l * 3 * 256 + h * 64 + 8 * pg;
#pragma unroll
            for (int j = 0; j < 8; ++j) {
                mu[0][j] = mu_[j]; mu[1][j] = mu_[256 + j]; mu[2][j] = mu_[512 + j];
                kkp[j] = p.in[15][l * 256 + h * 64 + 8 * pg + j]; kap[j] = p.in[16][l * 256 + h * 64 + 8 * pg + j];
            }
        }
        u32x4 rc, kc, vc, rp, kp, vp, omw, aav; f32x4 scv;
#define RWKV_LOAD(c) do { const int s_ = (c) * 32 + pi; const int t_ = dir ? (SEQ - 1 - s_) : s_; const int tp_ = dir ? t_ + 1 : t_ - 1; const size_t tk_ = (size_t)b * SEQ + t_; \
        const bf16_t* pc_ = PROJ + tk_ * PINC; const bf16_t* pp_ = PROJ + ((size_t)b * SEQ + tp_) * PINC; const bool hp_ = (s_ > 0); const u32x4 z_ = {0u, 0u, 0u, 0u}; \
        rc = *(const u32x4*)(pc_ + C_WR + h * 64 + 8 * pg); kc = *(const u32x4*)(pc_ + C_WK + h * 64 + 8 * pg); vc = *(const u32x4*)(pc_ + C_WV + h * 64 + 8 * pg); \
        rp = hp_ ? *(const u32x4*)(pp_ + C_WR + h * 64 + 8 * pg) : z_; kp = hp_ ? *(const u32x4*)(pp_ + C_WK + h * 64 + 8 * pg) : z_; vp = hp_ ? *(const u32x4*)(pp_ + C_WV + h * 64 + 8 * pg) : z_; \
        omw = *(const u32x4*)(WA + tk_ * 512 + h * 64 + 8 * pg); aav = *(const u32x4*)(WA + tk_ * 512 + 256 + h * 64 + 8 * pg); scv = *(const f32x4*)(SC + (tk_ * 4 + h) * 4); } while (0)
        RWKV_LOAD(0);
#pragma unroll 1
        for (int it = -2; it < 128; ++it) {
            if (it + 1 >= 0 && it + 1 < 128) {
                const int cj = it + 1;
                unsigned char* AR = RW_BUF_AR(cj); unsigned char* Mm = RW_BUF_MM(cj); unsigned char* LK = RW_BUF_LK(cj); float* LBq = RW_BUF_LB(cj);
                f32x4 macc[2][2];
#pragma unroll
                for (int m = 0; m < 2; ++m)
#pragma unroll
                    for (int n = 0; n < 2; ++n) macc[m][n] = (f32x4){0.f, 0.f, 0.f, 0.f};
#pragma unroll
                for (int kk2 = 0; kk2 < 2; ++kk2) {
                    bf16x8 af[2], bf_[2];
#pragma unroll
                    for (int m = 0; m < 2; ++m) af[m] = LDS_FRAG(AR, (32 * wr + 16 * m + fr) * P72 + (32 * kk2 + 8 * fq) * 2);
#pragma unroll
                    for (int n = 0; n < 2; ++n) bf_[n] = LDS_FRAG(BK, (32 * wc + 16 * n + fr) * P72 + (32 * kk2 + 8 * fq) * 2);
#pragma unroll
                    for (int m = 0; m < 2; ++m)
#pragma unroll
                        for (int n = 0; n < 2; ++n) macc[m][n] = MFMA16(bf_[n], af[m], macc[m][n]);
                }
#pragma unroll
                for (int m = 0; m < 2; ++m)
#pragma unroll
                    for (int n = 0; n < 2; ++n) {
                        const int i = 16 * m + fr, j0 = 16 * n + 4 * fq;
                        float mv[4];
#pragma unroll
                        for (int r = 0; r < 4; ++r) { const bool keep = (wr == 0) ? (j0 + r < i) : (j0 + r <= i); mv[r] = keep ? macc[m][n][r] : 0.f; }
                        if (wr == 0 && wc == 0) {
#pragma unroll
                            for (int r = 0; r < 4; ++r) LBq[i * 32 + r * 8 + (j0 >> 2)] = mv[r];
                        } else if (wr == 0) {
                            u32x2 o; o.x = cvt_pk_bf16(mv[0], mv[1]); o.y = cvt_pk_bf16(mv[2], mv[3]);
                            *(u32x2*)(LK + i * P40 + j0 * 2) = o;
                        } else {
                            u32x2 o; o.x = cvt_pk_bf16(mv[0], mv[1]); o.y = cvt_pk_bf16(mv[2], mv[3]);
                            *(u32x2*)(Mm + i * P72 + (32 * wc + j0) * 2) = o;
                        }
                    }
            }
            __syncthreads();
            const int cq = it + 2;
            float rs[8], kk[8], ka[8], km[8];
            if (cq < 128) {
                unsigned char* Ut = RW_BUF_UT(cq);
                float a[8], bq[8], ks[8], vs[8], om[8], av[8];
                unpack8(rc, a); unpack8(rp, bq);
#pragma unroll
                for (int j = 0; j < 8; ++j) rs[j] = a[j] + mu[0][j] * (bq[j] - a[j]);
                unpack8(kc, a); unpack8(kp, bq);
#pragma unroll
                for (int j = 0; j < 8; ++j) ks[j] = a[j] + mu[1][j] * (bq[j] - a[j]);
                unpack8(vc, a); unpack8(vp, bq);
#pragma unroll
                for (int j = 0; j < 8; ++j) vs[j] = a[j] + mu[2][j] * (bq[j] - a[j]);
                unpack8(omw, om); unpack8(aav, av);
#pragma unroll
                for (int j = 0; j < 8; ++j) {
                    kk[j] = ks[j] * kkp[j] * scv.x; ka[j] = kk[j] * av[j]; km[j] = ks[j] * (1.f + (av[j] - 1.f) * kap[j]);
                    lds_st16(Ut, (8 * pg + j) * P72 + (32 + ((pi + 8 * pg) & 31)) * 2, vs[j]);
                }
                *(f32x4*)(CUM + pi * 64 + 8 * pg) = (f32x4){om[0], om[1], om[2], om[3]}; *(f32x4*)(CUM + pi * 64 + 8 * pg + 4) = (f32x4){om[4], om[5], om[6], om[7]};
                if (cq + 1 < 128) RWKV_LOAD(cq + 1);
            }
            __syncthreads();
            if (cq < 128 && tid < 64) {
                float run = 0.f;
#pragma unroll 8
                for (int i = 0; i < 32; ++i) { run += CUM[i * 64 + tid]; CUM[i * 64 + tid] = run; }
            }
            __syncthreads();
            if (cq < 128) {
                unsigned char* AR = RW_BUF_AR(cq); unsigned char* Wt = RW_BUF_WT(cq); float* PC = RW_BUF_PC(cq);
                float ci[8], cp[8], cl[8];
                {
                    const f32x4 a0 = *(const f32x4*)(CUM + pi * 64 + 8 * pg), a1 = *(const f32x4*)(CUM + pi * 64 + 8 * pg + 4);
                    const f32x4 l0 = *(const f32x4*)(CUM + 31 * 64 + 8 * pg), l1 = *(const f32x4*)(CUM + 31 * 64 + 8 * pg + 4);
                    f32x4 p0 = {0.f, 0.f, 0.f, 0.f}, p1 = {0.f, 0.f, 0.f, 0.f};
                    if (pi > 0) { p0 = *(const f32x4*)(CUM + (pi - 1) * 64 + 8 * pg); p1 = *(const f32x4*)(CUM + (pi - 1) * 64 + 8 * pg + 4); }
                    ci[0] = a0.x; ci[1] = a0.y; ci[2] = a0.z; ci[3] = a0.w; ci[4] = a1.x; ci[5] = a1.y; ci[6] = a1.z; ci[7] = a1.w;
                    cl[0] = l0.x; cl[1] = l0.y; cl[2] = l0.z; cl[3] = l0.w; cl[4] = l1.x; cl[5] = l1.y; cl[6] = l1.z; cl[7] = l1.w;
                    cp[0] = p0.x; cp[1] = p0.y; cp[2] = p0.z; cp[3] = p0.w; cp[4] = p1.x; cp[5] = p1.y; cp[6] = p1.z; cp[7] = p1.w;
                }
                float ab[8], rb[8], bb[8], kb[8];
#pragma unroll
                for (int j = 0; j < 8; ++j) {
                    const float ei = __builtin_amdgcn_exp2f(ci[j]), en = frcp(ei), ep = __builtin_amdgcn_exp2f(cp[j]), pc = __builtin_amdgcn_exp2f(cl[j]);
                    ab[j] = -kk[j] * ep; rb[j] = rs[j] * ei; bb[j] = ka[j] * en; kb[j] = km[j] * en;
                    lds_st16(Wt, (8 * pg + j) * P72 + ((pi + 8 * pg) & 31) * 2, bb[j] * pc); lds_st16(Wt, (8 * pg + j) * P72 + (32 + ((pi + 8 * pg) & 31)) * 2, kb[j] * pc);
                    if (pi == 31) PC[8 * pg + j] = pc;
                }
                *(u32x4*)(AR + pi * P72 + 16 * pg) = pack8(ab); *(u32x4*)(AR + (32 + pi) * P72 + 16 * pg) = pack8(rb);
                *(u32x4*)(BK + pi * P72 + 16 * pg) = pack8(bb); *(u32x4*)(BK + (32 + pi) * P72 + 16 * pg) = pack8(kb);
            }
            __syncthreads();
        }
#undef RWKV_LOAD
        __builtin_amdgcn_s_setprio(0);
    } else {
        f32x4 sacc[2][2];
#pragma unroll
        for (int m = 0; m < 2; ++m)
#pragma unroll
            for (int n = 0; n < 2; ++n) sacc[m][n] = (f32x4){0.f, 0.f, 0.f, 0.f};
#pragma unroll 1
        for (int it = -2; it < 128; ++it) {
            if (it < 0) { __syncthreads(); __syncthreads(); __syncthreads(); __syncthreads(); continue; }
            const int c = it;
            unsigned char* AR = RW_BUF_AR(c); unsigned char* Ut = RW_BUF_UT(c); unsigned char* Wt = RW_BUF_WT(c); float* PC = RW_BUF_PC(c);
            unsigned char* Mm = RW_BUF_MM(c); unsigned char* LK = RW_BUF_LK(c); float* LBq = RW_BUF_LB(c);
            f32x4 xacc[2][2];
#pragma unroll
            for (int m = 0; m < 2; ++m)
#pragma unroll
                for (int n = 0; n < 2; ++n) xacc[m][n] = (f32x4){0.f, 0.f, 0.f, 0.f};
#pragma unroll
            for (int kk2 = 0; kk2 < 2; ++kk2) {
                bf16x8 af[2], sf[2];
#pragma unroll
                for (int m = 0; m < 2; ++m) af[m] = LDS_FRAG(AR, (32 * wr + 16 * m + fr) * P72 + (32 * kk2 + 8 * fq) * 2);
#pragma unroll
                for (int n = 0; n < 2; ++n) sf[n] = LDS_FRAG(S0b, (32 * wc + 16 * n + fr) * P72 + (32 * kk2 + 8 * fq) * 2);
#pragma unroll
                for (int m = 0; m < 2; ++m)
#pragma unroll
                    for (int n = 0; n < 2; ++n) xacc[m][n] = MFMA16(sf[n], af[m], xacc[m][n]);
            }
            if (wr == 0) {
#pragma unroll
                for (int m = 0; m < 2; ++m) {
                    const bf16x8 lf = LDS_FRAG(LK, (16 * m + fr) * P40 + 16 * fq);
#pragma unroll
                    for (int n = 0; n < 2; ++n) {
                        const bf16x8 vf = LDS_FRAG(Ut, (32 * wc + 16 * n + fr) * P72 + (32 + 8 * ((fq + 2 * n + (fr >> 3)) & 3)) * 2);
                        xacc[m][n] = MFMA16(vf, lf, xacc[m][n]);
                        *(f32x4*)(RH + (16 * m + fr) * 64 + 32 * wc + 16 * n + 4 * fq) = xacc[m][n];
                    }
                }
            }
            __syncthreads();
            {
                const int vv = 16 * wave + (lane >> 2), q = lane & 3;
                float sreg[8];
#pragma unroll
                for (int t = 0; t < 8; ++t) sreg[t] = 0.f;
                f32x4 la[4], lb[4]; float rhv[4];
#define P4_LD(slot, i) do { la[slot] = *(const f32x4*)(LBq + (i) * 32 + q * 8); lb[slot] = *(const f32x4*)(LBq + (i) * 32 + q * 8 + 4); rhv[slot] = RH[(i) * 64 + vv]; } while (0)
#define P4_ROW(i) do { if ((i) + 3 < 32) P4_LD(((i) + 3) & 3, (i) + 3); \
                    const f32x4 l0 = la[(i) & 3], l1 = lb[(i) & 3]; \
                    const float lv[8] = {l0.x, l0.y, l0.z, l0.w, l1.x, l1.y, l1.z, l1.w}; \
                    float p0 = 0.f, p1 = 0.f; \
                    _Pragma("unroll") for (int t = 0; t < 8; t += 2) { if (4 * t < (i)) p0 += lv[t] * sreg[t]; if (4 * (t + 1) < (i)) p1 += lv[t + 1] * sreg[t + 1]; } \
                    float part = p0 + p1; \
                    part += dpp_xor1(part); part += dpp_xor2(part); \
                    const float sa = rhv[(i) & 3] + part; \
                    if (((i) & 3) == q) sreg[(i) >> 2] = sa; } while (0)
                __syncthreads();
                P4_LD(0, 0); P4_LD(1, 1); P4_LD(2, 2);
#pragma unroll
                for (int i = 0; i < 32; ++i) P4_ROW(i);
#undef P4_ROW
#undef P4_LD
#pragma unroll
                for (int t = 0; t < 8; ++t) lds_st16(Ut, vv * P72 + ((4 * t + q + 8 * (vv >> 3)) & 31) * 2, sreg[t]);
            }
            __syncthreads();
            {
#pragma unroll
                for (int m = 0; m < 2; ++m) {
                    const f32x4 pc4 = *(const f32x4*)(PC + 32 * wr + 16 * m + 4 * fq);
#pragma unroll
                    for (int n = 0; n < 2; ++n) sacc[m][n] = sacc[m][n] * pc4;
                }
#pragma unroll
                for (int kk2 = 0; kk2 < 2; ++kk2) {
                    bf16x8 uf[2], wf[2];
#pragma unroll
                    for (int n = 0; n < 2; ++n) uf[n] = LDS_FRAG(Ut, (32 * wc + 16 * n + fr) * P72 + (32 * kk2 + 8 * ((fq + 2 * n + (fr >> 3)) & 3)) * 2);
#pragma unroll
                    for (int m = 0; m < 2; ++m) wf[m] = LDS_FRAG(Wt, (32 * wr + 16 * m + fr) * P72 + (32 * kk2 + 8 * ((fq + 2 * m + (fr >> 3)) & 3)) * 2);
#pragma unroll
                    for (int m = 0; m < 2; ++m)
#pragma unroll
                        for (int n = 0; n < 2; ++n) sacc[m][n] = MFMA16(wf[m], uf[n], sacc[m][n]);
                    if (wr == 1) {
#pragma unroll
                        for (int m = 0; m < 2; ++m) {
                            const bf16x8 mf = LDS_FRAG(Mm, (16 * m + fr) * P72 + (32 * kk2 + 8 * fq) * 2);
#pragma unroll
                            for (int n = 0; n < 2; ++n) xacc[m][n] = MFMA16(uf[n], mf, xacc[m][n]);
                        }
                    }
                }
#pragma unroll
                for (int m = 0; m < 2; ++m)
#pragma unroll
                    for (int n = 0; n < 2; ++n) {
                        u32x2 o; o.x = cvt_pk_bf16(sacc[m][n][0], sacc[m][n][1]); o.y = cvt_pk_bf16(sacc[m][n][2], sacc[m][n][3]);
                        *(u32x2*)(S0b + (32 * wc + 16 * n + fr) * P72 + (32 * wr + 16 * m + 4 * fq) * 2) = o;
                    }
                if (wr == 1) {
#pragma unroll
                    for (int m = 0; m < 2; ++m) {
                        const int s = c * 32 + 16 * m + fr; const int t = dir ? (SEQ - 1 - s) : s;
                        bf16_t* yo = YO + ((size_t)b * SEQ + t) * 256 + h * 64 + 32 * wc + 4 * fq;
#pragma unroll
                        for (int n = 0; n < 2; ++n) { u32x2 o; o.x = cvt_pk_bf16(xacc[m][n][0], xacc[m][n][1]); o.y = cvt_pk_bf16(xacc[m][n][2], xacc[m][n][3]); *(u32x2*)(yo + 16 * n) = o; }
                    }
                }
            }
            __syncthreads();
        }
    }
    __syncthreads();
}

__device__ __forceinline__ void rwkv_combine_item(const Params& p, int l, int item, unsigned char* smem) {
    int tid_ = (threadIdx.x & 255); asm volatile("" : "+v"(tid_)); const int tid = tid_, lane = tid & 63, wave = tid >> 6, fr = lane & 15, fq = lane >> 4;
    constexpr int PG = 272;
    unsigned char* XG = smem;
    const bf16_t* PROJ = WSP(bf16_t, WS_PROJ);
    const bf16_t* YFw = WSP(bf16_t, WS_YRW); const bf16_t* YBw = WSP(bf16_t, WS_YRW + 16 * MiB);
    const float* SCf = WSP(float, WS_SC); const float* SCb = SCf + (size_t)NTOK * 16;
    bf16_t* HB = WSP(bf16_t, WS_HB);
    const bf16_t* gup = wt_small(p, l) + SW_GUP;
    const size_t tok0 = (size_t)item * 64;
    const int t0 = (int)(tok0 & (SEQ - 1));
    __syncthreads();
    for (int i = tid; i < 64 * 16; i += NTHREADS) {
        const int r = i >> 4, ch = i & 15;
        const u32x4 v = *(const u32x4*)(PROJ + (tok0 + r) * PINC + C_WXG + 8 * ch);
        float f[8]; unpack8(v, f);
#pragma unroll
        for (int j = 0; j < 8; ++j) f[j] = sigmoidf_(f[j]);
        *(u32x4*)(XG + r * PG + 16 * ch) = pack8(f);
    }
    __syncthreads();
    const int h = wave;
    f32x4 G[4][4];
#pragma unroll
    for (int m = 0; m < 4; ++m)
#pragma unroll
        for (int n = 0; n < 4; ++n) G[m][n] = (f32x4){0.f, 0.f, 0.f, 0.f};
#pragma unroll
    for (int kk = 0; kk < 4; ++kk) {
        bf16x8 xf[4], gf[4];
#pragma unroll
        for (int m = 0; m < 4; ++m) xf[m] = LDS_FRAG(XG, (16 * m + fr) * PG + (32 * kk + 8 * fq) * 2);
#pragma unroll
        for (int n = 0; n < 4; ++n) gf[n] = *(const bf16x8*)(gup + (size_t)(64 * h + 16 * n + fr) * 128 + 32 * kk + 8 * fq);
#pragma unroll
        for (int m = 0; m < 4; ++m)
#pragma unroll
            for (int n = 0; n < 4; ++n) G[m][n] = MFMA16(gf[n], xf[m], G[m][n]);
    }
#pragma unroll
    for (int m = 0; m < 4; ++m) {
        const int i = 16 * m + fr; const size_t tok = tok0 + i; const int t = t0 + i;
        f32x4 yv[4]; float s1 = 0.f, s2 = 0.f;
#pragma unroll
        for (int n = 0; n < 4; ++n) {
            const int col = 64 * h + 16 * n + 4 * fq;
            const u32x2 a = *(const u32x2*)(YFw + tok * 256 + col), bq = *(const u32x2*)(YBw + tok * 256 + col);
            f32x4 v = {bf_lo(a.x) + bf_lo(bq.x), bf_hi(a.x) + bf_hi(bq.x), bf_lo(a.y) + bf_lo(bq.y), bf_hi(a.y) + bf_hi(bq.y)};
            yv[n] = v; s1 += (v[0] + v[1]) + (v[2] + v[3]); s2 += (v[0] * v[0] + v[1] * v[1]) + (v[2] * v[2] + v[3] * v[3]);
        }
        s1 += __shfl_xor(s1, 16); s1 += __shfl_xor(s1, 32); s2 += __shfl_xor(s2, 16); s2 += __shfl_xor(s2, 32);
        const float mean = s1 * (1.f / 64.f), var = fmaxf(s2 * (1.f / 64.f) - mean * mean, 0.f), rstd = rsqrtf(var + 64e-5f);
        const float cf = SCf[(tok * 4 + h) * 4 + 3], cbk = SCb[(tok * 4 + h) * 4 + 3];
#pragma unroll
        for (int n = 0; n < 4; ++n) {
            const int col = 64 * h + 16 * n + 4 * fq;
            const u32x2 vc = *(const u32x2*)(PROJ + tok * PINC + C_WV + col);
            u32x2 vp = {0u, 0u}, vn = {0u, 0u};
            if (t > 0) vp = *(const u32x2*)(PROJ + (tok - 1) * PINC + C_WV + col);
            if (t < SEQ - 1) vn = *(const u32x2*)(PROJ + (tok + 1) * PINC + C_WV + col);
            const f32x4 muv = *(const f32x4*)(p.in[7] + (size_t)l * 768 + 512 + col);
            const f32x4 gn = *(const f32x4*)(p.in[18] + l * 256 + col);
            const float c4[4] = {bf_lo(vc.x), bf_hi(vc.x), bf_lo(vc.y), bf_hi(vc.y)};
            const float p4[4] = {bf_lo(vp.x), bf_hi(vp.x), bf_lo(vp.y), bf_hi(vp.y)};
            const float n4[4] = {bf_lo(vn.x), bf_hi(vn.x), bf_lo(vn.y), bf_hi(vn.y)};
            float o4[4];
#pragma unroll
            for (int r = 0; r < 4; ++r) {
                const float vf = c4[r] + muv[r] * (p4[r] - c4[r]), vb = c4[r] + muv[r] * (n4[r] - c4[r]);
                o4[r] = ((yv[n][r] - mean) * rstd * gn[r] + cf * vf + cbk * vb) * G[m][n][r];
            }
            u32x2 o; o.x = cvt_pk_bf16(o4[0], o4[1]); o.y = cvt_pk_bf16(o4[2], o4[3]);
            *(u32x2*)(HB + hb_off(tok, 256 + col)) = o;
        }
    }
}

__device__ __forceinline__ void mix_finalize_item(const Params& p, int l, int item) {
    int tid_ = (threadIdx.x & 255); asm volatile("" : "+v"(tid_)); const int tid = tid_;
    const bf16_t* PROJ = WSP(bf16_t, WS_PROJ);
    bf16_t* HB = WSP(bf16_t, WS_HB);
    const int li = tid >> 2, lc = tid & 3;
    const size_t tok = (size_t)item * 64 + li;
#pragma unroll 1
    for (int h = 0; h < 4; ++h) {
        const int col = 64 * h + 16 * lc;
#pragma unroll
        for (int mx = 0; mx < 3; ++mx) {
            const int ocol = (mx == 0) ? 0 : (mx == 1) ? 768 : 512;
            const bf16_t* yf = yt_buf(p, mx) + tok * 256 + col; bf16_t* yb = HB + hb_off(tok, ocol + col);
            const int gcol = (mx == 0) ? C_RG : (mx == 1) ? C_GOG : C_LG;
            const u32x4 f0 = *(const u32x4*)yf, f1 = *(const u32x4*)(yf + 8), b0 = *(const u32x4*)yb, b1 = *(const u32x4*)(yb + 8);
            const u32x4 g0 = *(const u32x4*)(PROJ + tok * PINC + gcol + col), g1 = *(const u32x4*)(PROJ + tok * PINC + gcol + col + 8);
            float y[16], t2[16], g[16];
            unpack8(f0, y); unpack8(f1, y + 8); unpack8(b0, t2); unpack8(b1, t2 + 8); unpack8(g0, g); unpack8(g1, g + 8);
            float s1 = 0.f, s2 = 0.f;
#pragma unroll
            for (int j = 0; j < 16; ++j) { y[j] += t2[j]; s1 += y[j]; s2 += y[j] * y[j]; }
            float o[16];
            if (mx == 2) {
#pragma unroll
                for (int j = 0; j < 16; ++j) o[j] = y[j] * geluf_(g[j]);
            } else {
                s1 += dpp_xor1(s1); s1 += dpp_xor2(s1); s2 += dpp_xor1(s2); s2 += dpp_xor2(s2);
                const float mean = (mx == 0) ? s1 * (1.f / 64.f) : 0.f;
                const float var = (mx == 0) ? fmaxf(s2 * (1.f / 64.f) - mean * mean, 0.f) : s2 * (1.f / 64.f);
                const float rstd = rsqrtf(var + 1e-6f);
                const float* gn = p.in[mx == 0 ? 6 : 26] + l * 256 + col;
#pragma unroll
                for (int j = 0; j < 16; ++j) o[j] = (y[j] - mean) * rstd * gn[j] * siluf_(g[j]);
            }
            *(u32x4*)yb = pack8(o); *(u32x4*)(yb + 8) = pack8(o + 8);
        }
    }
}

constexpr int SYNCS_RET = 1 + 64 * 3 + 1, SYNCS_GLA = 1 + 64 * 6 + 1, SYNCS_LRU = 2 + 64 * 3 + 1;
__device__ __forceinline__ void phase_mixers(const Params& p, int l, unsigned char* smem) {
    const int vb = VB_;
    for (int job_ = blockIdx.x; job_ < 256; job_ += gridDim.x) {
        const int job = __builtin_amdgcn_readfirstlane(job_);
        if (job < 64) rwkv_chain(p, l, job >> 3, (job >> 1) & 3, job & 1, smem);
        else if (vb == 0) {
            if (job < 128) ret_chain(p, l, (job - 64) >> 3, ((job - 64) >> 1) & 3, job & 1, smem);
            else if (job < 192) gla_chain(p, l, (job - 128) >> 3, ((job - 128) >> 1) & 3, job & 1, smem);
            else lru_chain(p, l, (job - 192) >> 3, ((job - 192) >> 1) & 3, job & 1, smem);
        } else {
            const int n = job < 128 ? SYNCS_RET : job < 192 ? SYNCS_GLA : SYNCS_LRU;
#pragma unroll 1
            for (int i = 0; i < n; ++i) __builtin_amdgcn_s_barrier();
        }
    }
    {
        const int nbk = gridDim.x, first = nbk > 64 ? 64 : 0;
        if ((int)blockIdx.x >= first) conv_expert_items(p, l, smem + vb * LDS_MAIN, ((int)blockIdx.x - first) * 2 + vb, (nbk - first) * 2);
    }
}
__device__ __forceinline__ void phase_rwkv_combine(const Params& p, int l, unsigned char* smem) {
    constexpr int NIT = NTOK / 64;
    for (int k = 0; k < (NIT + NVB_ - 1) / NVB_; ++k) {
        const int it = VBID_ + k * NVB_;
        rwkv_combine_item(p, l, it < NIT ? it : NIT - 1, smem);
        if (it < NIT) mix_finalize_item(p, l, it);
    }
}


constexpr int N_PHASES = 22;
#ifdef DBG_SKIP_MASK
#define ST_EN(k) (!((DBG_SKIP_MASK >> (k)) & 1))
#elif !defined(ONLY_STAGE)
#define ST_EN(k) 1
#else
#define ST_EN(k) ((k) == ONLY_STAGE)
#endif
__device__ __forceinline__ void run_stage(const Params& p, int s, int l, unsigned char* smem_all) {
    unsigned char* smem = smem_all + VB_ * LDS_MAIN;
    switch (s) {
        case 10: phase_p0(p, smem); break;
        case 11: phase_norm(p, 2, p.in[33], DEPTH - 1, smem); break;
        case 0: phase_rotary_table(p); phase_norm(p, l == 0 ? 0 : 1, p.in[2] + l * D, l - 1, smem); break;
        case 1: phase_gemm(p, G_PROJ, l, smem_all); break;
        case 9: phase_rwkv_prepass(p, l, smem); break;
        case 2: phase_mixers(p, l, smem_all); break;
        case 3: phase_rwkv_combine(p, l, smem); break;
        case 4: phase_gemm(p, G_OUT, l, smem_all); break;
        case 5: phase_ffnnorm_router(p, l, smem); break;
        case 6: phase_topk(p, smem_all); break;
        case 7: phase_gemm(p, G_MOE1, l, smem_all); break;
        default: phase_gemm(p, G_MOE2, l, smem_all); break;
    }
}
__device__ __forceinline__ int stage_of_phase(int ph) { if (ph == 0) return 10; if (ph == N_PHASES - 1) return 11; const int q = (ph - 1) % 10; return q == 2 ? 9 : (q < 2 ? q : q - 1); }
__device__ __forceinline__ int layer_of_phase(int ph) { return ph >= 11 ? 1 : 0; }

__global__ void __launch_bounds__(BTHREADS, 2) hybrid_fwd(Params p) {
    extern __shared__ __attribute__((aligned(16))) unsigned char smem[];
    volatile unsigned* st = (volatile unsigned*)(smem + 2 * LDS_MAIN);
    if (threadIdx.x < 16) st[threadIdx.x] = 0u;
    __syncthreads();
    unsigned* ctl = (unsigned*)(p.ws + WS_CTL);
    XcdBarrier bar; bar.bar = ctl + CW_BAR; bar.x = 0; bar.st = st;
#if ONE_LAUNCH
    bar = xcd_barrier_post(ctl + CW_BAR, st);
#if defined(DBG_DUP_MASK)
#define DUP_(S, L) if ((DBG_DUP_MASK >> (S)) & 1) { xcd_barrier(bar); run_stage(p, (S), (L), smem); }
#elif defined(DBG_DUP_STAGE)
#define DUP_(S, L) if ((S) == DBG_DUP_STAGE) { xcd_barrier(bar); run_stage(p, (S), (L), smem); }
#else
#define DUP_(S, L)
#endif
#define RUN_(S, L) { run_stage(p, (S), (L), smem); DUP_(S, L) xcd_barrier(bar); }
#define LAYER_(L) RUN_(0, L) RUN_(1, L) RUN_(9, L) RUN_(2, L) RUN_(3, L) RUN_(4, L) RUN_(5, L) RUN_(6, L) RUN_(7, L) RUN_(8, L)
    run_stage(p, 10, 0, smem);
    LAYER_(0)
    LAYER_(1)
    run_stage(p, 11, 1, smem);
#else
#pragma unroll 1
    for (int ph = p.phase_lo; ph < p.phase_hi; ++ph) run_stage(p, stage_of_phase(ph), __builtin_amdgcn_readfirstlane(layer_of_phase(ph)), smem);
#endif
}

extern "C" void kernel_launch(void* const* d_in, const int* in_sizes, int n_in, void* d_out, int out_size, void* d_ws, size_t ws_size, hipStream_t stream) {
    static int grid = 0;
    if (grid == 0) {
        if (n_in != 34 || out_size != NTOK * D || ws_size < WS_END) { fprintf(stderr, "kernel_launch: unexpected shapes (n_in %d out %d ws %zu need %zu)\n", n_in, out_size, ws_size, (size_t)WS_END); grid = -1; return; }
        int dev = 0, cus = 0, per_cu = 0;
        hipGetDevice(&dev);
        hipDeviceGetAttribute(&cus, hipDeviceAttributeMultiprocessorCount, dev);
        hipFuncSetAttribute((const void*)hybrid_fwd, hipFuncAttributeMaxDynamicSharedMemorySize, LDS_BYTES);
        hipOccupancyMaxActiveBlocksPerMultiprocessor(&per_cu, (const void*)hybrid_fwd, BTHREADS, LDS_BYTES);
        if (per_cu < 1) { fprintf(stderr, "kernel_launch: occupancy query says %d blocks/CU\n", per_cu); per_cu = 1; }
        if (per_cu > 1) per_cu = 1;
        grid = cus * per_cu;
        (void)hipGetLastError();
    }
    if (grid < 0) return;
    hipMemsetAsync((char*)d_ws + WS_CTL, 0, 1 * MiB, stream);
    Params p{};
    for (int i = 0; i < 34; ++i) p.in[i] = (const float*)d_in[i];
    p.out = (float*)d_out; p.ws = (unsigned char*)d_ws;
#if ONE_LAUNCH
    p.phase_lo = 0; p.phase_hi = N_PHASES;
    void* args[] = {&p};
    hipError_t e = hipLaunchCooperativeKernel((const void*)hybrid_fwd, dim3(grid), dim3(BTHREADS), args, LDS_BYTES, stream);
    if (e != hipSuccess) fprintf(stderr, "cooperative launch failed: %s (grid %d)\n", hipGetErrorString(e), grid);
#else
    for (int ph = 0; ph < N_PHASES; ++ph) {
        p.phase_lo = ph; p.phase_hi = ph + 1;
        hipLaunchKernelGGL(hybrid_fwd, dim3(grid), dim3(BTHREADS), LDS_BYTES, stream, p);
    }
#endif
}
```

```cpp
#include <hip/hip_runtime.h>
#include <stdint.h>
#include <stdio.h>

#ifndef ONE_LAUNCH
#define ONE_LAUNCH 1
#endif

typedef unsigned short bf16_t;
typedef short bf16x8 __attribute__((ext_vector_type(8)));
typedef float f32x4 __attribute__((ext_vector_type(4)));
typedef float f32x2 __attribute__((ext_vector_type(2)));
typedef unsigned u32x4 __attribute__((ext_vector_type(4)));
typedef unsigned u32x2 __attribute__((ext_vector_type(2)));

constexpr int D = 1024, BATCH = 8, SEQ = 4096, NTOK = BATCH * SEQ, DEPTH = 2;
constexpr int INC = 3344;
constexpr int PINC = 3456;
constexpr int C_RQ = 0, C_RK = 256, C_RV = 512, C_RG = 768, C_WR = 1024, C_WK = 1280, C_WV = 1536, C_WXW = 1792, C_WXA = 1856,
              C_WXG = 1920, C_LX = 2048, C_LG = 2304, C_GQ = 2560, C_GK = 2688, C_GV = 2816, C_GOG = 3072, C_GXA = 3328;
constexpr int NE = 16, CAP = 512;
constexpr int NTHREADS = 256;
constexpr int BTHREADS = 512;
#define VB_   (__builtin_amdgcn_readfirstlane((int)(threadIdx.x >> 8)))
#define VBID_ ((int)blockIdx.x + (int)gridDim.x * VB_)
#define NVB_  (2 * (int)gridDim.x)
constexpr int LDS_MAIN = 73728, LDS_BYTES = 2 * LDS_MAIN + 64;

constexpr size_t MiB = 1u << 20;
constexpr size_t WS_CTL = 0;
constexpr size_t WS_WTIN = 1 * MiB;
constexpr size_t WS_WTOUT = 15 * MiB;
constexpr size_t WS_WSMALL = 19 * MiB;
constexpr size_t WS_AFF = 20 * MiB;
constexpr size_t WS_IDX = 22 * MiB;
constexpr size_t WS_GATE = 22 * MiB + 256 * 1024;
constexpr size_t WS_BONC = 22 * MiB + 512 * 1024;
constexpr size_t WS_INV = 24 * MiB;
constexpr size_t WS_WTEXP = 26 * MiB;
constexpr size_t WS_HB = 122 * MiB;
constexpr size_t WS_PROJ = 186 * MiB;
constexpr size_t WS_YT = 402 * MiB;
constexpr size_t WS_HID = WS_PROJ;
constexpr size_t WS_OUTB = WS_PROJ + 128 * MiB;
constexpr size_t WS_ROT = 442 * MiB;
constexpr size_t WS_WA = 450 * MiB;
constexpr size_t WS_YRW = 514 * MiB;
constexpr size_t WS_END = 546 * MiB;
constexpr size_t WS_SC = WS_AFF;
constexpr int SW_WUP = 0;
constexpr int SW_AUP = 32768;
constexpr int SW_GUP = 65536;
constexpr int SW_LRU = 98304;
constexpr int SW_LAYER = 262144;
constexpr int CW_QUEUE = 16;
constexpr int CW_BAR = 4096;

struct Params {
    const float* in[34];
    float* out;
    unsigned char* ws;
    int phase_lo, phase_hi;
};

__device__ __forceinline__ int opaque_tid() { int t = (threadIdx.x & 255); asm volatile("" : "+v"(t)); return t; }
typedef __bf16 bf16x2v __attribute__((ext_vector_type(2)));
__device__ __forceinline__ unsigned cvt_pk_bf16(float lo, float hi) { const f32x2 f = {lo, hi}; const bf16x2v b = __builtin_convertvector(f, bf16x2v); return __builtin_bit_cast(unsigned, b); }
__device__ __forceinline__ float bf_lo(unsigned u) { return __uint_as_float(u << 16); }
__device__ __forceinline__ float bf_hi(unsigned u) { return __uint_as_float(u & 0xffff0000u); }
__device__ __forceinline__ bf16_t f2bf(float f) { return (bf16_t)(cvt_pk_bf16(f, 0.f) & 0xffffu); }
__device__ __forceinline__ float frcp(float x) { return __builtin_amdgcn_rcpf(x); }
__device__ __forceinline__ float sigmoidf_(float x) { return frcp(1.f + __expf(-x)); }
__device__ __forceinline__ float siluf_(float x) { return x * sigmoidf_(x); }
__device__ __forceinline__ float softplusf_(float x) { return fmaxf(x, 0.f) + __logf(1.f + __expf(-fabsf(x))); }
__device__ __forceinline__ float tanhf_(float x) { float xc = fminf(fmaxf(x, -15.f), 15.f); float t = __expf(2.f * xc); return (t - 1.f) * frcp(t + 1.f); }
__device__ __forceinline__ float geluf_(float x) { return 0.5f * x * (1.f + tanhf_(0.7978845608028654f * (x + 0.044715f * x * x * x))); }
__device__ __forceinline__ void unpack8(const u32x4 v, float* f) {
    f[0] = bf_lo(v.x); f[1] = bf_hi(v.x); f[2] = bf_lo(v.y); f[3] = bf_hi(v.y); f[4] = bf_lo(v.z); f[5] = bf_hi(v.z); f[6] = bf_lo(v.w); f[7] = bf_hi(v.w);
}
__device__ __forceinline__ u32x4 pack8(const float* f) {
    u32x4 v; v.x = cvt_pk_bf16(f[0], f[1]); v.y = cvt_pk_bf16(f[2], f[3]); v.z = cvt_pk_bf16(f[4], f[5]); v.w = cvt_pk_bf16(f[6], f[7]); return v;
}
__device__ __forceinline__ float wave_sum(float v) {
#pragma unroll
    for (int o = 1; o < 64; o <<= 1) v += __shfl_xor(v, o);
    return v;
}
__device__ __forceinline__ float dpp_xor1(float x) { return __int_as_float(__builtin_amdgcn_mov_dpp(__float_as_int(x), 0xB1, 0xF, 0xF, true)); }
__device__ __forceinline__ float dpp_hmirror(float x) { return __int_as_float(__builtin_amdgcn_mov_dpp(__float_as_int(x), 0x141, 0xF, 0xF, true)); }
__device__ __forceinline__ float dpp_xor2(float x) { return __int_as_float(__builtin_amdgcn_mov_dpp(__float_as_int(x), 0x4E, 0xF, 0xF, true)); }
#define MFMA16(a, b, c) __builtin_amdgcn_mfma_f32_16x16x32_bf16((a), (b), (c), 0, 0, 0)
#define LDS_FRAG(base, byteoff) (*(const bf16x8*)((base) + (byteoff)))
__device__ __forceinline__ u32x4 pair_swap16(const u32x2 a, const u32x2 b) {
    const u32x2 r0 = __builtin_amdgcn_permlane16_swap(a.x, b.x, false, false), r1 = __builtin_amdgcn_permlane16_swap(a.y, b.y, false, false);
    return (u32x4){r0.x, r1.x, r0.y, r1.y};
}
__device__ __forceinline__ int swz8(int fq) { return ((fq & 1) << 4) | ((fq >> 1) << 3); }

#define XB_TMO      128
#define XB_XCNT(j)  (256  + 64 * (j))
#define XB_XSUB(j)  (1280 + 64 * (j))
#define XB_XGEN(j)  (2304 + 64 * (j))
#define XB_TOP      3328
#define XB_TOPGEN   3392
#define XB_SPIN_CAP (1u << 22)
__device__ __forceinline__ unsigned xb_ld(unsigned* p) { return __hip_atomic_load(p, __ATOMIC_RELAXED, __HIP_MEMORY_SCOPE_AGENT); }
__device__ __forceinline__ unsigned xb_add(unsigned* p, unsigned v) { return __hip_atomic_fetch_add(p, v, __ATOMIC_RELAXED, __HIP_MEMORY_SCOPE_AGENT); }
__device__ __forceinline__ unsigned xb_xcc_id() { return (unsigned)__builtin_amdgcn_s_getreg((3 << 11) | 20) & 0xFu; }
#define XB_SPIN(cond, bar) do { unsigned _sp = 0; while (cond) { __builtin_amdgcn_s_sleep(1); \
    if ((++_sp & 255u) == 0u) { if (xb_ld(&(bar)[XB_TMO])) break; if (_sp > XB_SPIN_CAP) { atomicAdd(&(bar)[XB_TMO], 1u); break; } } } } while (0)
struct XcdBarrier { unsigned* bar; unsigned x; volatile unsigned* st; };
__device__ __forceinline__ XcdBarrier xcd_barrier_post(unsigned* bar, volatile unsigned* st) {
    XcdBarrier b; b.bar = bar; b.x = xb_xcc_id(); b.st = st;
    if (threadIdx.x == 0) (void)xb_add(&bar[XB_XCNT(b.x)], 1u);
    return b;
}
__device__ __forceinline__ void xcd_barrier_complete(unsigned* bar, unsigned x, unsigned& nloc, unsigned& nx) {
    const unsigned G = gridDim.x;
    unsigned sum, cnt, mine, sp = 0u;
    for (;;) {
        sum = 0u; cnt = 0u; mine = 0u;
#pragma unroll
        for (unsigned j = 0; j < 16; ++j) { const unsigned c = xb_ld(&bar[XB_XCNT(j)]); sum += c; cnt += (c > 0u) ? 1u : 0u; mine = (j == x) ? c : mine; }
        if (sum == G) break;
        __builtin_amdgcn_s_sleep(1);
        if ((++sp & 255u) == 0u) { if (xb_ld(&bar[XB_TMO])) break; if (sp > XB_SPIN_CAP) { atomicAdd(&bar[XB_TMO], 1u); break; } }
    }
    nloc = mine > 0u ? mine : 1u; nx = cnt > 0u ? cnt : 1u;
}
__device__ __forceinline__ void xcd_barrier(const XcdBarrier& b) {
    asm volatile("s_waitcnt vmcnt(0)" ::: "memory");
    __syncthreads();
    if (threadIdx.x == 0) {
        unsigned* bar = b.bar;
        __builtin_amdgcn_s_waitcnt(0);
        unsigned nloc = b.st[0], nx = b.st[1];
        if (nloc == 0u) { xcd_barrier_complete(bar, b.x, nloc, nx); b.st[0] = nloc; b.st[1] = nx; }
        const unsigned old = xb_add(&bar[XB_XSUB(b.x)], 1u);
        const unsigned gen = old / nloc;
        if (old + 1u == (gen + 1u) * nloc) {
            __builtin_amdgcn_fence(__ATOMIC_RELEASE, "agent");
            asm volatile("s_waitcnt vmcnt(0)" ::: "memory");
            const unsigned og = xb_add(&bar[XB_TOP], 1u);
            const unsigned tg = og / nx;
            if (og + 1u == (tg + 1u) * nx) xb_add(&bar[XB_TOPGEN], 1u);
            else XB_SPIN(xb_ld(&bar[XB_TOPGEN]) == tg, bar);
            __builtin_amdgcn_fence(__ATOMIC_ACQUIRE, "");
            xb_add(&bar[XB_XGEN(b.x)], 1u);
            asm volatile("s_waitcnt vmcnt(0)" ::: "memory");
        } else {
            XB_SPIN(xb_ld(&bar[XB_XGEN(b.x)]) == gen, bar);
            __builtin_amdgcn_fence(__ATOMIC_ACQUIRE, "agent");
            asm volatile("s_waitcnt vmcnt(0)" ::: "memory");
        }
    }
    __syncthreads();
}

#define WSP(T, off) ((T*)(p.ws + (off)))
__device__ __forceinline__ bf16_t* wt_in(const Params& p, int l) { return WSP(bf16_t, WS_WTIN + (size_t)l * 7 * MiB); }
__device__ __forceinline__ bf16_t* wt_out(const Params& p, int l) { return WSP(bf16_t, WS_WTOUT + (size_t)l * 2 * MiB); }
__device__ __forceinline__ bf16_t* wt_small(const Params& p, int l) { return WSP(bf16_t, WS_WSMALL) + (size_t)l * SW_LAYER; }
__device__ __forceinline__ size_t hb_off(size_t tok, int col) { return ((size_t)(col >> 5) * NTOK + tok) * 32 + (col & 31); }
__device__ __forceinline__ size_t hid_off(size_t row, int col) { return ((size_t)(col >> 5) * 65536 + row) * 32 + (col & 31); }
__device__ __forceinline__ bf16_t* yt_buf(const Params& p, int i) { return WSP(bf16_t, WS_YT + (size_t)i * 16 * MiB); }

__device__ __forceinline__ void transpose_tile(const float* __restrict__ src, int lds_, int K, int N, bf16_t* __restrict__ dst, int ldd, int kt, int nt, float* tile, int kb = 0) {
    int tid_ = (threadIdx.x & 255); asm volatile("" : "+v"(tid_)); const int tid = tid_, k0 = kt * 64, n0 = nt * 64;
#pragma unroll
    for (int i = 0; i < 4; ++i) {
        const int r = (tid >> 4) + 16 * i, c = (tid & 15) * 4;
        f32x4 v = {0.f, 0.f, 0.f, 0.f};
        if (k0 + r < K) {
            if (n0 + c + 3 < N) v = *(const f32x4*)(src + (size_t)(k0 + r) * lds_ + n0 + c);
            else { if (n0 + c < N) v.x = src[(size_t)(k0 + r) * lds_ + n0 + c]; if (n0 + c + 1 < N) v.y = src[(size_t)(k0 + r) * lds_ + n0 + c + 1]; if (n0 + c + 2 < N) v.z = src[(size_t)(k0 + r) * lds_ + n0 + c + 2]; }
        }
        tile[r * 65 + c] = v.x; tile[r * 65 + c + 1] = v.y; tile[r * 65 + c + 2] = v.z; tile[r * 65 + c + 3] = v.w;
    }
    __syncthreads();
    {
        const int n = tid >> 2, kc = (tid & 3) * 16;
        if (n0 + n < N) {
            float f[16];
#pragma unroll
            for (int j = 0; j < 16; ++j) f[j] = tile[(kc + j) * 65 + n];
            u32x4 a = pack8(f), b = pack8(f + 8);
            bf16_t* o = kb ? dst + ((size_t)((k0 + kc) >> 5) * kb + n0 + n) * 32 + ((k0 + kc) & 31) : dst + (size_t)(n0 + n) * ldd + k0 + kc;
            *(u32x4*)o = a; *(u32x4*)(o + 8) = b;
        }
    }
    __syncthreads();
}

__device__ __forceinline__ void phase_p0(const Params& p, unsigned char* smem) {
    float* tile = (float*)smem;
    const int bid = VBID_, nb = NVB_;
    constexpr int J_IN = 16 * 53, J_OUT = 256, J_WUP = 8, J_AUP = 8, J_GUP = 8, J_LRU = 16, J_L = J_IN + J_OUT + J_WUP + J_AUP + J_GUP + J_LRU;
    for (int k = 0; k < (2 * J_L + nb - 1) / nb; ++k) {
        const int job = bid + k * nb;
        if (job >= 2 * J_L) { __syncthreads(); __syncthreads(); continue; }
        const int l = job / J_L; int r = job % J_L;
        bf16_t* sw = wt_small(p, l);
        if (r < J_IN) { transpose_tile(p.in[3] + (size_t)l * D * INC, INC, D, INC, wt_in(p, l), D, r / 53, r % 53, tile, INC); continue; } r -= J_IN;
        if (r < J_OUT) { transpose_tile(p.in[4] + (size_t)l * D * D, D, D, D, wt_out(p, l), D, r / 16, r % 16, tile, D); continue; } r -= J_OUT;
        if (r < J_WUP) { const int dir = r / 4; transpose_tile(p.in[11] + (size_t)(l * 2 + dir) * 64 * 256, 256, 64, 256, sw + SW_WUP + dir * 16384, 64, 0, r % 4, tile); continue; } r -= J_WUP;
        if (r < J_AUP) { const int dir = r / 4; transpose_tile(p.in[13] + (size_t)(l * 2 + dir) * 64 * 256, 256, 64, 256, sw + SW_AUP + dir * 16384, 64, 0, r % 4, tile); continue; } r -= J_AUP;
        if (r < J_GUP) { transpose_tile(p.in[14] + (size_t)l * 128 * 256, 256, 128, 256, sw + SW_GUP, 128, r / 4, r % 4, tile); continue; } r -= J_GUP;
        { transpose_tile(p.in[21] + (size_t)(l * 16 + r) * 4096, 64, 64, 64, sw + SW_LRU + r * 4096, 64, 0, 0, tile); }
    }
}

__device__ __forceinline__ void phase_rotary_table(const Params& p) {
    const int bid = VBID_, nb = NVB_;
    const int* pos = (const int*)p.in[1];
    f32x2* rot = WSP(f32x2, WS_ROT);
    for (int i = bid * NTHREADS + opaque_tid(); i < NTOK * 32; i += nb * NTHREADS) {
        const int tok = i >> 5, j = i & 31;
        const float inv = exp2f(-(float)j * (13.287712379549449f / 32.f));
        const float ang = (float)pos[tok] * inv;
        float s, c; sincosf(ang, &s, &c);
        rot[i] = (f32x2){c, s};
    }
}

__device__ __forceinline__ void conv_expert_items(const Params& p, int l, unsigned char* smem, int vbid, int nvb) {
    float* tile = (float*)smem;
    bf16_t* dstbase = WSP(bf16_t, WS_WTEXP);
    constexpr int nitems = 48 * 256;
    int tid_ = (threadIdx.x & 255); asm volatile("" : "+v"(tid_)); const int tid = tid_;
    const int r0 = tid >> 4, c0 = (tid & 15) * 4;
    const int n = tid >> 2, kc = (tid & 3) * 16;
    f32x4 v[4];
#define CONV_LOAD(it_) do { const int mi_ = (it_) >> 8, e_ = mi_ / 3, w_ = mi_ - 3 * e_; \
        const float* s_ = p.in[30 + w_] + ((size_t)l * NE + e_) * D * D + (size_t)((((it_) & 255) >> 4) * 64) * D + ((it_) & 15) * 64; \
        _Pragma("unroll") for (int i = 0; i < 4; ++i) v[i] = *(const f32x4*)(s_ + (size_t)(r0 + 16 * i) * D + c0); } while (0)
    const int last = nitems - 1, trips = (nitems + nvb - 1) / nvb;
    { const int itf = vbid < nitems ? vbid : last; CONV_LOAD(itf); }
    __syncthreads();
    for (int k = 0; k < trips; ++k) {
        const int itr = vbid + k * nvb, it = itr < nitems ? itr : last;
        const int mi = it >> 8, t = it & 255;
#pragma unroll
        for (int i = 0; i < 4; ++i) { const int r = r0 + 16 * i; tile[r * 65 + c0] = v[i].x; tile[r * 65 + c0 + 1] = v[i].y; tile[r * 65 + c0 + 2] = v[i].z; tile[r * 65 + c0 + 3] = v[i].w; }
        __syncthreads();
        if (k + 1 < trips) { const int itn = itr + nvb < nitems ? itr + nvb : last; CONV_LOAD(itn); }
        {
            float f[16];
#pragma unroll
            for (int j = 0; j < 16; ++j) f[j] = tile[(kc + j) * 65 + n];
            const int k0 = (t >> 4) * 64, n0 = (t & 15) * 64;
            bf16_t* o = dstbase + (size_t)mi * D * D + ((size_t)((k0 + kc) >> 5) * D + n0 + n) * 32 + ((k0 + kc) & 31);
            *(u32x4*)o = pack8(f); *(u32x4*)(o + 8) = pack8(f + 8);
        }
        __syncthreads();
    }
#undef CONV_LOAD
}

__device__ __forceinline__ void phase_norm(const Params& p, int mode, const float* __restrict__ wgt, int l, unsigned char* smem) {
    int tid_ = (threadIdx.x & 255); asm volatile("" : "+v"(tid_)); const int tid = tid_, lane = tid & 63, wave = tid >> 6;
    float* rw = (float*)smem;
    if (mode == 3) {
        const float* rsrc = p.in[28] + (size_t)l * D * NE;
        for (int i = tid; i < D * NE; i += NTHREADS) {
            const int d = i >> 4, e = i & 15;
            const int j = d >> 8, ln = (d & 255) >> 2, ii = d & 3;
            rw[((j * 4 + ii) * 16 + e) * 64 + ln] = rsrc[i];
        }
        __syncthreads();
    }
    const float* xin = (mode == 0) ? p.in[0] : p.out;
    bf16_t* HB = WSP(bf16_t, WS_HB);
    const int* INV = WSP(int, WS_INV);
    const bf16_t* OUTB = WSP(bf16_t, WS_OUTB);
    const int gw = VBID_ * 4 + wave, ngw = NVB_ * 4;
    for (int row = gw; row < NTOK; row += ngw) {
        f32x4 v[4];
#pragma unroll
        for (int j = 0; j < 4; ++j) v[j] = *(const f32x4*)(xin + (size_t)row * D + 4 * lane + 256 * j);
        if (mode == 1 || mode == 2) {
            const int b = row >> 12;
            const int myinv = (lane < 16) ? INV[(size_t)row * 16 + lane] : -1;
#pragma unroll 1
            for (int e = 0; e < 16; ++e) {
                const int slot = __shfl(myinv, e);
                if (slot >= 0) {
                    const bf16_t* orow = OUTB + ((size_t)(b * 16 + e) * CAP + slot) * D;
#pragma unroll
                    for (int j = 0; j < 4; ++j) {
                        const u32x2 o = *(const u32x2*)(orow + 4 * lane + 256 * j);
                        v[j].x += bf_lo(o.x); v[j].y += bf_hi(o.x); v[j].z += bf_lo(o.y); v[j].w += bf_hi(o.y);
                    }
                }
            }
            if (mode == 1) {
#pragma unroll
                for (int j = 0; j < 4; ++j) *(f32x4*)(p.out + (size_t)row * D + 4 * lane + 256 * j) = v[j];
            }
        }
        float ss = 0.f;
#pragma unroll
        for (int j = 0; j < 4; ++j) ss += v[j].x * v[j].x + v[j].y * v[j].y + v[j].z * v[j].z + v[j].w * v[j].w;
        ss = wave_sum(ss);
        const float rstd = rsqrtf(ss * (1.f / D) + 1e-6f);
#pragma unroll
        for (int j = 0; j < 4; ++j) { const f32x4 w = *(const f32x4*)(wgt + 4 * lane + 256 * j); v[j] = v[j] * rstd * w; }
        if (mode == 2) {
#pragma unroll
            for (int j = 0; j < 4; ++j) *(f32x4*)(p.out + (size_t)row * D + 4 * lane + 256 * j) = v[j];
        } else {
#pragma unroll
            for (int j = 0; j < 4; ++j) { u32x2 o; o.x = cvt_pk_bf16(v[j].x, v[j].y); o.y = cvt_pk_bf16(v[j].z, v[j].w); *(u32x2*)(HB + hb_off(row, 4 * lane + 256 * j)) = o; }
        }
        if (mode == 3) {
            float lg[16];
#pragma unroll
            for (int e = 0; e < 16; ++e) lg[e] = 0.f;
#pragma unroll
            for (int j = 0; j < 4; ++j) {
                const float xv[4] = {v[j].x, v[j].y, v[j].z, v[j].w};
#pragma unroll
                for (int ii = 0; ii < 4; ++ii) {
#pragma unroll
                    for (int e = 0; e < 16; ++e) lg[e] += xv[ii] * rw[((j * 4 + ii) * 16 + e) * 64 + lane];
                    __builtin_amdgcn_sched_barrier(0);
                }
            }
            float mx = -1e30f;
#pragma unroll
            for (int e = 0; e < 16; ++e) { lg[e] = wave_sum(lg[e]) + p.in[29][l * NE + e]; mx = fmaxf(mx, lg[e]); }
            float sum = 0.f;
#pragma unroll
            for (int e = 0; e < 16; ++e) { lg[e] = __expf(lg[e] - mx); sum += lg[e]; }
            const float inv = 1.f / sum;
            float mine = 0.f;
#pragma unroll
            for (int e = 0; e < 16; ++e) mine = (lane == e) ? lg[e] * inv : mine;
            if (lane < 16) { const int b = row >> 12, t = row & 4095; WSP(float, WS_AFF)[((size_t)b * NE + lane) * SEQ + t] = mine; }
        }
    }
}

__device__ __forceinline__ void phase_ffnnorm_router(const Params& p, int l, unsigned char* smem) {
    int tid_ = (threadIdx.x & 255); asm volatile("" : "+v"(tid_)); const int tid = tid_, lane = tid & 63, wave = tid >> 6, fr = lane & 15, fq = lane >> 4;
    constexpr int PR = 2064;
    unsigned char* RWh = smem; unsigned char* RWl = smem + 16 * PR;
    const float* wgt = p.in[27] + l * D;
    {
        const float* rsrc = p.in[28] + (size_t)l * D * NE;
        for (int i = tid; i < D * NE; i += NTHREADS) {
            const int k = i >> 4, e = i & 15;
            const float v = rsrc[i] * wgt[k];
            const unsigned hb = cvt_pk_bf16(v, 0.f) & 0xffffu;
            const float hf = __uint_as_float(hb << 16);
            *(bf16_t*)(RWh + e * PR + k * 2) = (bf16_t)hb;
            *(bf16_t*)(RWl + e * PR + k * 2) = (bf16_t)(cvt_pk_bf16(v - hf, 0.f) & 0xffffu);
        }
        __syncthreads();
    }
    bf16_t* HB = WSP(bf16_t, WS_HB);
    float* AFF = WSP(float, WS_AFF);
    const int gw = VBID_ * 4 + wave, ngw = NVB_ * 4;
    for (int grp = gw; grp < NTOK / 16; grp += ngw) {
        const size_t row = (size_t)grp * 16 + fr;
        const float* xr = p.out + row * D + 8 * fq;
        f32x4 acc = {0.f, 0.f, 0.f, 0.f};
        float ss = 0.f;
#pragma unroll 4
        for (int ks = 0; ks < 32; ++ks) {
            const f32x4 x0 = *(const f32x4*)(xr + 32 * ks), x1 = *(const f32x4*)(xr + 32 * ks + 4);
            const float xv[8] = {x0.x, x0.y, x0.z, x0.w, x1.x, x1.y, x1.z, x1.w};
            unsigned hp[4], lp[4];
#pragma unroll
            for (int j = 0; j < 4; ++j) {
                ss += xv[2 * j] * xv[2 * j] + xv[2 * j + 1] * xv[2 * j + 1];
                hp[j] = cvt_pk_bf16(xv[2 * j], xv[2 * j + 1]);
                lp[j] = cvt_pk_bf16(xv[2 * j] - bf_lo(hp[j]), xv[2 * j + 1] - bf_hi(hp[j]));
            }
            const u32x4 ahu = {hp[0], hp[1], hp[2], hp[3]}, alu = {lp[0], lp[1], lp[2], lp[3]};
            const bf16x8 ah = __builtin_bit_cast(bf16x8, ahu), al = __builtin_bit_cast(bf16x8, alu);
            const bf16x8 bh = LDS_FRAG(RWh, fr * PR + (32 * ks + 8 * fq) * 2), bl = LDS_FRAG(RWl, fr * PR + (32 * ks + 8 * fq) * 2);
            acc = MFMA16(bh, ah, acc); acc = MFMA16(bh, al, acc); acc = MFMA16(bl, ah, acc);
        }
        ss += __shfl_xor(ss, 16); ss += __shfl_xor(ss, 32);
        const float rstd = rsqrtf(ss * (1.f / D) + 1e-6f);
        float lg[4], mx = -1e30f;
#pragma unroll
        for (int r = 0; r < 4; ++r) { lg[r] = acc[r] * rstd + p.in[29][l * NE + 4 * fq + r]; mx = fmaxf(mx, lg[r]); }
        mx = fmaxf(mx, __shfl_xor(mx, 16)); mx = fmaxf(mx, __shfl_xor(mx, 32));
        float sum = 0.f;
#pragma unroll
        for (int r = 0; r < 4; ++r) { lg[r] = __expf(lg[r] - mx); sum += lg[r]; }
        sum += __shfl_xor(sum, 16); sum += __shfl_xor(sum, 32);
        const float inv = 1.f / sum;
        {
            const int b = (int)(row >> 12), t = (int)(row & 4095);
#pragma unroll
            for (int r = 0; r < 4; ++r) AFF[((size_t)b * NE + 4 * fq + r) * SEQ + t] = lg[r] * inv;
        }
        bf16_t* hr = HB + row * 32 + 8 * fq;
#pragma unroll 4
        for (int ks = 0; ks < 32; ++ks) {
            const f32x4 x0 = *(const f32x4*)(xr + 32 * ks), x1 = *(const f32x4*)(xr + 32 * ks + 4);
            const f32x4 w0 = *(const f32x4*)(wgt + 32 * ks + 8 * fq), w1 = *(const f32x4*)(wgt + 32 * ks + 8 * fq + 4);
            u32x4 o;
            o.x = cvt_pk_bf16(x0.x * rstd * w0.x, x0.y * rstd * w0.y); o.y = cvt_pk_bf16(x0.z * rstd * w0.z, x0.w * rstd * w0.w);
            o.z = cvt_pk_bf16(x1.x * rstd * w1.x, x1.y * rstd * w1.y); o.w = cvt_pk_bf16(x1.z * rstd * w1.z, x1.w * rstd * w1.w);
            *(u32x4*)(hr + (size_t)ks * NTOK * 32) = o;
        }
    }
}

__device__ __forceinline__ void phase_topk(const Params& p, unsigned char* smem) {
    int tid_ = threadIdx.x; asm volatile("" : "+v"(tid_)); const int tid = tid_, lane = tid & 63, wave = tid >> 6;
    int* scnt = (int*)smem;
    const float* AFF = WSP(float, WS_AFF);
    int* IDX = WSP(int, WS_IDX); float* GATE = WSP(float, WS_GATE); int* INV = WSP(int, WS_INV);
    for (int be = blockIdx.x; be < BATCH * NE; be += gridDim.x) {
        const int b = be / NE, e = be % NE;
        unsigned key[8];
#pragma unroll
        for (int j = 0; j < 8; ++j) key[j] = __float_as_uint(AFF[(size_t)be * SEQ + j * 512 + tid]);
        unsigned prefix = 0u; int remaining = CAP;
#pragma unroll 1
        for (int bit = 30; bit >= 0; --bit) {
            const unsigned cand = prefix | (1u << bit);
            int c = 0;
#pragma unroll
            for (int j = 0; j < 8; ++j) c += ((key[j] >> bit) == (cand >> bit)) ? 1 : 0;
            c = (int)wave_sum((float)c);
            __syncthreads();
            if (lane == 0) scnt[wave] = c;
            __syncthreads();
            const int tot = scnt[0] + scnt[1] + scnt[2] + scnt[3] + scnt[4] + scnt[5] + scnt[6] + scnt[7];
            if (tot >= remaining) prefix = cand; else remaining -= tot;
        }
        int gt_base = 0, eq_base = 0;
#pragma unroll 1
        for (int j = 0; j < 8; ++j) {
            const bool gt = key[j] > prefix, eq = key[j] == prefix;
            const unsigned long long mg = __ballot(gt), me = __ballot(eq);
            const unsigned long long lower = (lane == 0) ? 0ull : (~0ull >> (64 - lane));
            const int pg = __popcll(mg & lower), pe = __popcll(me & lower);
            __syncthreads();
            if (lane == 0) { scnt[wave] = __popcll(mg); scnt[8 + wave] = __popcll(me); }
            __syncthreads();
            int wg = 0, we = 0, tg = 0, te = 0;
#pragma unroll
            for (int w = 0; w < 8; ++w) { const int a = scnt[w], c2 = scnt[8 + w]; if (w < wave) { wg += a; we += c2; } tg += a; te += c2; }
            const int g_before = gt_base + wg + pg, e_before = eq_base + we + pe;
            const int t = j * 512 + tid;
            int slot = -1;
            if (gt) slot = g_before + min(e_before, remaining);
            else if (eq && e_before < remaining) slot = g_before + e_before;
            if (slot >= 0) { IDX[(size_t)be * CAP + slot] = t; GATE[(size_t)be * CAP + slot] = __uint_as_float(key[j]); }
            INV[((size_t)b * SEQ + t) * 16 + e] = slot;
            gt_base += tg; eq_base += te;
        }
        __syncthreads();
    }
}

enum { G_PROJ = 0, G_OUT = 1, G_MOE1 = 2, G_MOE2 = 3 };
struct GemmJob {
    const bf16_t* A; const bf16_t* B;
    int mode, mt, nt;
    int be, e;
    int l;
};
__device__ __forceinline__ int gswz(int r16) { return (0x78 >> (2 * ((r16 >> 2) & 3))) & 3; }
__device__ __forceinline__ void gemm_tile(const Params& p, const GemmJob& g, unsigned char* smem) {
    int tid_ = threadIdx.x; asm volatile("" : "+v"(tid_)); const int tid = tid_, lane = tid & 63, wave = __builtin_amdgcn_readfirstlane(tid >> 6);
    const int wr = wave >> 2, wc = wave & 3, fr = lane & 15, fq = lane >> 4;
    const int srow = lane >> 2;
    const int csrc = (lane & 3) ^ gswz(srow);
    const bf16_t* aptr[2]; const bf16_t* bptr[2];
    const int* IDX = WSP(int, WS_IDX);
#pragma unroll
    for (int i = 0; i < 2; ++i) {
        const int r = (i * 8 + wave) * 16 + srow;
        size_t arow;
        if (g.mode == G_MOE1) {
            const int wr_ = r >> 7, m = (r >> 4) & 7, f = r & 15;
            arow = (size_t)(m >> 2) * (D * D / 32) + g.nt * 128 + wr_ * 64 + (m & 3) * 16 + f;
            aptr[i] = g.B + arow * 32 + csrc * 8;
            continue;
        }
        else if (g.mode == G_MOE2) arow = (size_t)g.be * CAP + g.mt * 256 + r;
        else arow = (size_t)g.mt * 256 + r;
        aptr[i] = g.A + arow * 32 + csrc * 8;
    }
#pragma unroll
    for (int i = 0; i < 2; ++i) {
        const int r = (i * 8 + wave) * 16 + srow;
        size_t brow;
        if (g.mode == G_MOE1) {
            brow = (size_t)(g.be >> 4) * SEQ + IDX[(size_t)g.be * CAP + g.mt * 256 + r];
            bptr[i] = g.A + brow * 32 + csrc * 8;
            continue;
        }
        else { int c = g.nt * 256 + r; if (g.mode == G_PROJ && c >= INC) c = INC - 1; brow = c; }
        bptr[i] = g.B + brow * 32 + csrc * 8;
    }
    asm volatile("s_waitcnt lgkmcnt(0)" ::: "memory");
    __builtin_amdgcn_s_barrier();
    asm volatile("" ::: "memory");
    f32x4 acc[8][4];
#pragma unroll
    for (int m = 0; m < 8; ++m)
#pragma unroll
        for (int n = 0; n < 4; ++n) acc[m][n] = (f32x4){0.f, 0.f, 0.f, 0.f};
#define G_STAGE(buf, kt) do { _Pragma("unroll") for (int _i = 0; _i < 2; ++_i) \
        __builtin_amdgcn_global_load_lds((const unsigned*)(aptr[_i] + (size_t)(kt) * astep), (unsigned*)(smem + (buf) * 32768 + (_i * 8 + wave) * 1024), 16, 0, 0); \
        _Pragma("unroll") for (int _i = 0; _i < 2; ++_i) \
        __builtin_amdgcn_global_load_lds((const unsigned*)(bptr[_i] + (size_t)(kt) * bstep), (unsigned*)(smem + (buf) * 32768 + 16384 + (_i * 8 + wave) * 1024), 16, 0, 0); } while (0)
    const int bstep = __builtin_amdgcn_readfirstlane((g.mode == G_PROJ ? INC : g.mode == G_MOE1 ? NTOK : D) * 32);
    const int astep = __builtin_amdgcn_readfirstlane((g.mode == G_MOE2 ? 65536 : g.mode == G_MOE1 ? D : NTOK) * 32);
    G_STAGE(0, 0); G_STAGE(1, 1); G_STAGE(2, 2);
    const int coff = (fq ^ gswz(fr)) * 16;
    const int aoff = (wr * 128 + fr) * 64 + coff, boff = 16384 + (wc * 64 + fr) * 64 + coff;
#pragma unroll 1
    for (int t = 0; t < 32; ++t) {
        if (t < 30) asm volatile("s_waitcnt vmcnt(8)" ::: "memory"); else if (t == 30) asm volatile("s_waitcnt vmcnt(4)" ::: "memory"); else asm volatile("s_waitcnt vmcnt(0)" ::: "memory");
        __builtin_amdgcn_s_barrier();
        if (t + 3 < 32) G_STAGE((t + 3) & 3, t + 3);
        const unsigned char* sb = smem + (t & 3) * 32768;
        bf16x8 af[8], bfv[4];
#pragma unroll
        for (int n = 0; n < 4; ++n) bfv[n] = LDS_FRAG(sb, boff + n * 1024);
        af[0] = LDS_FRAG(sb, aoff); af[1] = LDS_FRAG(sb, aoff + 1024);
        __builtin_amdgcn_sched_barrier(0);
#pragma unroll
        for (int gq = 0; gq < 4; ++gq) {
            if (gq < 3) { af[2 * gq + 2] = LDS_FRAG(sb, aoff + (2 * gq + 2) * 1024); af[2 * gq + 3] = LDS_FRAG(sb, aoff + (2 * gq + 3) * 1024); }
            __builtin_amdgcn_sched_barrier(0);
#pragma unroll
            for (int mm = 0; mm < 2; ++mm)
#pragma unroll
                for (int n = 0; n < 4; ++n) acc[2 * gq + mm][n] = (g.mode == G_MOE1) ? MFMA16(af[2 * gq + mm], bfv[n], acc[2 * gq + mm][n]) : MFMA16(bfv[n], af[2 * gq + mm], acc[2 * gq + mm][n]);
            __builtin_amdgcn_sched_barrier(0);
        }
    }
#undef G_STAGE
    if (g.mode == G_PROJ) {
        bf16_t* PROJ = WSP(bf16_t, WS_PROJ);
        if (g.nt < 2) {
            const f32x2* ROT = WSP(f32x2, WS_ROT);
            const float ksc = (g.nt >= 1) ? 0.125f : 1.f;
#pragma unroll
            for (int m = 0; m < 8; ++m) {
                const size_t row = (size_t)g.mt * 256 + wr * 128 + m * 16 + fr;
#pragma unroll
                for (int n = 0; n < 2; ++n) {
                    const f32x4 cs0 = *(const f32x4*)(ROT + row * 32 + n * 16 + fq * 4), cs1 = *(const f32x4*)(ROT + row * 32 + n * 16 + fq * 4 + 2);
                    const float co[4] = {cs0.x, cs0.z, cs1.x, cs1.z}, si[4] = {cs0.y, cs0.w, cs1.y, cs1.w};
#pragma unroll
                    for (int r = 0; r < 4; ++r) {
                        const float x1 = acc[m][n][r], x2 = acc[m][n + 2][r];
                        acc[m][n][r] = (x1 * co[r] - x2 * si[r]) * ksc; acc[m][n + 2][r] = (x1 * si[r] + x2 * co[r]) * ksc;
                    }
                }
            }
        }
        if (g.nt * 256 + wc * 64 < PINC)
#pragma unroll
        for (int m = 0; m < 8; ++m) {
            const size_t row = (size_t)g.mt * 256 + wr * 128 + m * 16 + fr;
            bf16_t* orow = PROJ + row * PINC + g.nt * 256 + wc * 64 + swz8(fq);
#pragma unroll
            for (int n1 = 0; n1 < 2; ++n1) {
                u32x2 a, b;
                a.x = cvt_pk_bf16(acc[m][2 * n1][0], acc[m][2 * n1][1]); a.y = cvt_pk_bf16(acc[m][2 * n1][2], acc[m][2 * n1][3]);
                b.x = cvt_pk_bf16(acc[m][2 * n1 + 1][0], acc[m][2 * n1 + 1][1]); b.y = cvt_pk_bf16(acc[m][2 * n1 + 1][2], acc[m][2 * n1 + 1][3]);
                *(u32x4*)(orow + 32 * n1) = pair_swap16(a, b);
            }
        }
    } else if (g.mode == G_OUT) {
        const float* xin = (g.l == 0) ? p.in[0] : p.out;
#pragma unroll
        for (int m = 0; m < 8; ++m) {
            const size_t row = (size_t)g.mt * 256 + wr * 128 + m * 16 + fr;
#pragma unroll
            for (int n = 0; n < 4; ++n) {
                const int col = g.nt * 256 + wc * 64 + n * 16 + fq * 4;
                const f32x4 x = *(const f32x4*)(xin + row * D + col);
                *(f32x4*)(p.out + row * D + col) = x + acc[m][n];
            }
            __builtin_amdgcn_sched_barrier(0);
        }
    } else if (g.mode == G_MOE1) {
        bf16_t* HID = WSP(bf16_t, WS_HID);
#pragma unroll
        for (int n = 0; n < 4; ++n) {
            const size_t row = (size_t)g.be * CAP + g.mt * 256 + wc * 64 + n * 16 + fr;
#pragma unroll
            for (int q1 = 0; q1 < 2; ++q1) {
                u32x2 ab[2];
#pragma unroll
                for (int j = 0; j < 2; ++j) {
                    const int mq = 2 * q1 + j;
                    float h[4];
#pragma unroll
                    for (int r = 0; r < 4; ++r) h[r] = siluf_(acc[mq][n][r]) * acc[mq + 4][n][r];
                    ab[j].x = cvt_pk_bf16(h[0], h[1]); ab[j].y = cvt_pk_bf16(h[2], h[3]);
                }
                *(u32x4*)(HID + hid_off(row, g.nt * 128 + wr * 64 + 32 * q1 + swz8(fq))) = pair_swap16(ab[0], ab[1]);
            }
        }
    } else {
        bf16_t* OUTB = WSP(bf16_t, WS_OUTB);
        const float* GATE = WSP(float, WS_GATE);
#pragma unroll
        for (int m = 0; m < 8; ++m) {
            const int sl = g.mt * 256 + wr * 128 + m * 16 + fr;
            const float gt = GATE[(size_t)g.be * CAP + sl];
            const size_t row = (size_t)g.be * CAP + sl;
            bf16_t* orow = OUTB + row * D + g.nt * 256 + wc * 64 + swz8(fq);
#pragma unroll
            for (int n1 = 0; n1 < 2; ++n1) {
                u32x2 a, b;
                a.x = cvt_pk_bf16(acc[m][2 * n1][0] * gt, acc[m][2 * n1][1] * gt); a.y = cvt_pk_bf16(acc[m][2 * n1][2] * gt, acc[m][2 * n1][3] * gt);
                b.x = cvt_pk_bf16(acc[m][2 * n1 + 1][0] * gt, acc[m][2 * n1 + 1][1] * gt); b.y = cvt_pk_bf16(acc[m][2 * n1 + 1][2] * gt, acc[m][2 * n1 + 1][3] * gt);
                *(u32x4*)(orow + 32 * n1) = pair_swap16(a, b);
            }
        }
    }
}

__device__ __forceinline__ void phase_gemm(const Params& p, int mode, int l, unsigned char* smem) {
    const int bid = blockIdx.x, nb = gridDim.x;
    GemmJob g; g.mode = mode; g.l = l; g.be = 0; g.e = 0;
    if (mode == G_PROJ) {
        g.A = WSP(bf16_t, WS_HB); g.B = wt_in(p, l);
        if ((nb & 7) == 0) {
            const int xcd = bid & 7, j = bid >> 3, nj = nb >> 3;
            for (int q = j; q < 16 * 14; q += nj) { g.mt = (q / 14) * 8 + xcd; g.nt = q % 14; gemm_tile(p, g, smem); }
        } else
        for (int t = bid; t < 128 * 14; t += nb) { g.mt = t / 14; g.nt = t % 14; gemm_tile(p, g, smem); }
    } else if (mode == G_OUT) {
        g.A = WSP(bf16_t, WS_HB); g.B = wt_out(p, l);
        if ((nb & 7) == 0) {
            const int xcd = bid & 7, j = bid >> 3, nj = nb >> 3;
            for (int q = j; q < 16 * 4; q += nj) { g.mt = (q / 4) * 8 + xcd; g.nt = q % 4; gemm_tile(p, g, smem); }
        } else
        for (int t = bid; t < 128 * 4; t += nb) { g.mt = t / 4; g.nt = t % 4; gemm_tile(p, g, smem); }
    } else if (mode == G_MOE1) {
        for (int t = bid; t < 16 * 8 * 16; t += nb) {
            const int e = t >> 7, nt = (t >> 4) & 7, bm = t & 15, b = bm >> 1, mt = bm & 1;
            g.e = e; g.be = b * 16 + e; g.mt = mt; g.nt = nt;
            g.A = WSP(bf16_t, WS_HB); g.B = WSP(bf16_t, WS_WTEXP) + (size_t)(e * 3) * D * D;
            gemm_tile(p, g, smem);
        }
    } else {
        for (int t = bid; t < 16 * 4 * 16; t += nb) {
            const int e = t >> 6, nt = (t >> 4) & 3, bm = t & 15, b = bm >> 1, mt = bm & 1;
            g.e = e; g.be = b * 16 + e; g.mt = mt; g.nt = nt;
            g.A = WSP(bf16_t, WS_HID); g.B = WSP(bf16_t, WS_WTEXP) + (size_t)(e * 3 + 2) * D * D;
            gemm_tile(p, g, smem);
        }
    }
}

constexpr int P72 = 144;
constexpr int P40 = 80;
__device__ __forceinline__ void lds_st16(unsigned char* base, int off, float v) { *(bf16_t*)(base + off) = f2bf(v); }

__device__ __forceinline__ void ret_chain(const Params& p, int l, int b, int h, int dir, unsigned char* smem) {
    int tid_ = (threadIdx.x & 255); asm volatile("" : "+v"(tid_)); const int tid = tid_, lane = tid & 63, wave = tid >> 6, wr = wave >> 1, wc = wave & 1, fr = lane & 15, fq = lane >> 4;
    unsigned char* Qs = smem; unsigned char* Ks = smem + 9216; unsigned char* KtZ = smem + 18432; unsigned char* Vt = smem + 27648;
    unsigned char* Ps = smem + 36864; unsigned char* St = smem + 46080; float* stats = (float*)(smem + 55296);
    const bf16_t* PROJ = WSP(bf16_t, WS_PROJ);
    const f32x2* ROT = WSP(f32x2, WS_ROT);
    bf16_t* YF = dir ? WSP(bf16_t, WS_HB) : yt_buf(p, 0); constexpr int YCB = 0;
    const int li = tid >> 2, lp = tid & 3;
    {
        __syncthreads();
        const float lg2 = p.in[5][(l * 2 + dir) * 4 + h] * 1.4426950408889634f;
        const float cdec = exp2f(lg2 * 64.f);
        f32x4 sacc[2][2];
#pragma unroll
        for (int m = 0; m < 2; ++m)
#pragma unroll
            for (int n = 0; n < 2; ++n) sacc[m][n] = (f32x4){0.f, 0.f, 0.f, 0.f};
        for (int i = tid; i < 9216 / 4; i += NTHREADS) ((unsigned*)St)[i] = 0u;
        u32x4 q1, q2, k1, k2, v1, v2;
#define RET_LOAD(c) do { const int s_ = (c) * 64 + li; const size_t tok_ = (size_t)b * SEQ + (dir ? (SEQ - 1 - s_) : s_); const bf16_t* pr_ = PROJ + tok_ * PINC + h * 64 + 8 * lp; \
        q1 = *(const u32x4*)(pr_ + C_RQ); q2 = *(const u32x4*)(pr_ + C_RQ + 32); k1 = *(const u32x4*)(pr_ + C_RK); k2 = *(const u32x4*)(pr_ + C_RK + 32); \
        v1 = *(const u32x4*)(pr_ + C_RV); v2 = *(const u32x4*)(pr_ + C_RV + 32); } while (0)
        RET_LOAD(0);
#pragma unroll 1
        for (int c = 0; c < 64; ++c) {
            __syncthreads();
            {
                *(u32x4*)(Qs + li * P72 + 16 * lp) = q1; *(u32x4*)(Qs + li * P72 + 64 + 16 * lp) = q2;
                *(u32x4*)(Ks + li * P72 + 16 * lp) = k1; *(u32x4*)(Ks + li * P72 + 64 + 16 * lp) = k2;
                const float zeta = exp2f(lg2 * (float)(63 - li));
                float ka[8], kb[8];
                unpack8(k1, ka); unpack8(k2, kb);
#pragma unroll
                for (int j = 0; j < 8; ++j) { lds_st16(KtZ, (8 * lp + j) * P72 + li * 2, ka[j] * zeta); lds_st16(KtZ, (32 + 8 * lp + j) * P72 + li * 2, kb[j] * zeta); }
                const unsigned vw[8] = {v1.x, v1.y, v1.z, v1.w, v2.x, v2.y, v2.z, v2.w};
#pragma unroll
                for (int j = 0; j < 4; ++j) {
                    *(bf16_t*)(Vt + (8 * lp + 2 * j) * P72 + li * 2) = (bf16_t)(vw[j] & 0xffffu); *(bf16_t*)(Vt + (8 * lp + 2 * j + 1) * P72 + li * 2) = (bf16_t)(vw[j] >> 16);
                    *(bf16_t*)(Vt + (32 + 8 * lp + 2 * j) * P72 + li * 2) = (bf16_t)(vw[4 + j] & 0xffffu); *(bf16_t*)(Vt + (32 + 8 * lp + 2 * j + 1) * P72 + li * 2) = (bf16_t)(vw[4 + j] >> 16);
                }
            }
            __syncthreads();
            f32x4 yc[2][2];
            {
                f32x4 sc[2][2];
#pragma unroll
                for (int m = 0; m < 2; ++m)
#pragma unroll
                    for (int n = 0; n < 2; ++n) { sc[m][n] = (f32x4){0.f, 0.f, 0.f, 0.f}; yc[m][n] = (f32x4){0.f, 0.f, 0.f, 0.f}; }
#pragma unroll
                for (int kk = 0; kk < 2; ++kk) {
                    bf16x8 qf[2], kf[2], sf[2];
#pragma unroll
                    for (int m = 0; m < 2; ++m) qf[m] = LDS_FRAG(Qs, (32 * wr + 16 * m + fr) * P72 + (32 * kk + 8 * fq) * 2);
#pragma unroll
                    for (int n = 0; n < 2; ++n) { kf[n] = LDS_FRAG(Ks, (32 * wc + 16 * n + fr) * P72 + (32 * kk + 8 * fq) * 2); sf[n] = LDS_FRAG(St, (32 * wc + 16 * n + fr) * P72 + (32 * kk + 8 * fq) * 2); }
#pragma unroll
                    for (int m = 0; m < 2; ++m)
#pragma unroll
                        for (int n = 0; n < 2; ++n) { sc[m][n] = MFMA16(kf[n], qf[m], sc[m][n]); yc[m][n] = MFMA16(sf[n], qf[m], yc[m][n]); }
                    __builtin_amdgcn_sched_barrier(0);
                }
#pragma unroll
                for (int m = 0; m < 2; ++m)
#pragma unroll
                    for (int n = 0; n < 2; ++n) {
                        const int i = 32 * wr + 16 * m + fr, j0 = 32 * wc + 16 * n + 4 * fq;
                        float pv[4];
#pragma unroll
                        for (int r = 0; r < 4; ++r) { const int dlt = i - (j0 + r); pv[r] = (dlt >= 0) ? sc[m][n][r] * exp2f(lg2 * (float)dlt) : 0.f; }
                        u32x2 o; o.x = cvt_pk_bf16(pv[0], pv[1]); o.y = cvt_pk_bf16(pv[2], pv[3]);
                        *(u32x2*)(Ps + i * P72 + j0 * 2) = o;
                    }
            }
            __syncthreads();
            if (c + 1 < 64) RET_LOAD(c + 1);
            f32x4 y[2][2];
#pragma unroll
            for (int m = 0; m < 2; ++m)
#pragma unroll
                for (int n = 0; n < 2; ++n) { y[m][n] = (f32x4){0.f, 0.f, 0.f, 0.f}; sacc[m][n] = sacc[m][n] * cdec; }
#pragma unroll
            for (int kk = 0; kk < 2; ++kk) {
                bf16x8 pf[2], vf[2], zf[2];
#pragma unroll
                for (int m = 0; m < 2; ++m) { pf[m] = LDS_FRAG(Ps, (32 * wr + 16 * m + fr) * P72 + (32 * kk + 8 * fq) * 2); zf[m] = LDS_FRAG(KtZ, (32 * wr + 16 * m + fr) * P72 + (32 * kk + 8 * fq) * 2); }
#pragma unroll
                for (int n = 0; n < 2; ++n) vf[n] = LDS_FRAG(Vt, (32 * wc + 16 * n + fr) * P72 + (32 * kk + 8 * fq) * 2);
#pragma unroll
                for (int m = 0; m < 2; ++m)
#pragma unroll
                    for (int n = 0; n < 2; ++n) { y[m][n] = MFMA16(vf[n], pf[m], y[m][n]); sacc[m][n] = MFMA16(zf[m], vf[n], sacc[m][n]); }
                __builtin_amdgcn_sched_barrier(0);
            }
#pragma unroll
            for (int m = 0; m < 2; ++m)
#pragma unroll
                for (int n = 0; n < 2; ++n) {
                    u32x2 o; o.x = cvt_pk_bf16(sacc[m][n][0], sacc[m][n][1]); o.y = cvt_pk_bf16(sacc[m][n][2], sacc[m][n][3]);
                    *(u32x2*)(St + (32 * wc + 16 * n + fr) * P72 + (32 * wr + 16 * m + 4 * fq) * 2) = o;
                }
            {
#pragma unroll
                for (int m = 0; m < 2; ++m) {
                    const int i = 32 * wr + 16 * m + fr; const float xi = exp2f(lg2 * (float)(i + 1));
                    const int s = c * 64 + i; const size_t tok = (size_t)b * SEQ + (dir ? (SEQ - 1 - s) : s);
#pragma unroll
                    for (int n = 0; n < 2; ++n) {
                        const f32x4 yy = y[m][n] + yc[m][n] * xi;
                        u32x2 o; o.x = cvt_pk_bf16(yy[0], yy[1]); o.y = cvt_pk_bf16(yy[2], yy[3]);
                        { const int yc_ = h * 64 + 32 * wc + 16 * n + 4 * fq; *(u32x2*)(YF + (dir ? hb_off(tok, YCB + yc_) : tok * 256 + yc_)) = o; }
                    }
                }
            }
        }
#undef RET_LOAD
        __syncthreads();
    }
}

__device__ __forceinline__ void gla_chain(const Params& p, int l, int b, int h, int dir, unsigned char* smem) {
    int tid_ = (threadIdx.x & 255); asm volatile("" : "+v"(tid_)); const int tid = tid_, lane = tid & 63, wave = tid >> 6, wr = wave >> 1, wc = wave & 1, fr = lane & 15, fq = lane >> 4;
    unsigned char* Qd = smem; unsigned char* Kd = smem + 5120; unsigned char* KeT = smem + 10240; unsigned char* Vt = smem + 14848;
    unsigned char* Ps = smem + 24064; unsigned char* St = smem + 33280;
    float* bcum = (float*)(smem + 38400);
    float* gsum = (float*)(smem + 46592);
    float* xas = (float*)(smem + 47616);
    float* stats = (float*)(smem + 51712);
    const bf16_t* PROJ = WSP(bf16_t, WS_PROJ);
    bf16_t* YF = dir ? WSP(bf16_t, WS_HB) : yt_buf(p, 1); constexpr int YCB = 768;
    const int li = tid >> 2, lc = tid & 3;
    const int ck = tid & 31, cg = tid >> 5;
    {
        __syncthreads();
        float au[16];
#pragma unroll
        for (int r = 0; r < 16; ++r) au[r] = p.in[24][((size_t)(l * 2 + dir) * 16 + r) * 128 + h * 32 + ck];
        const float ab = p.in[25][(l * 2 + dir) * 128 + h * 32 + ck];
        f32x4 sacc[2];
        sacc[0] = (f32x4){0.f, 0.f, 0.f, 0.f}; sacc[1] = (f32x4){0.f, 0.f, 0.f, 0.f};
        for (int i = tid; i < 5120 / 4; i += NTHREADS) ((unsigned*)St)[i] = 0u;
#pragma unroll 1
        for (int c = 0; c < 64; ++c) {
            __syncthreads();
            if (tid < 128) {
                const int i = tid >> 1, hf = tid & 1; const int s = c * 64 + i; const size_t tok = (size_t)b * SEQ + (dir ? (SEQ - 1 - s) : s);
                const u32x4 xv = *(const u32x4*)(PROJ + tok * PINC + C_GXA + 8 * hf);
                float f[8]; unpack8(xv, f);
#pragma unroll
                for (int j = 0; j < 8; ++j) xas[i * 16 + 8 * hf + j] = f[j];
            }
            const int s3 = c * 64 + li; const size_t tok3 = (size_t)b * SEQ + (dir ? (SEQ - 1 - s3) : s3);
            const u32x4 qv = *(const u32x4*)(PROJ + tok3 * PINC + C_GQ + h * 32 + 8 * lc);
            const u32x4 kv = *(const u32x4*)(PROJ + tok3 * PINC + C_GK + h * 32 + 8 * lc);
            const u32x4 va = *(const u32x4*)(PROJ + tok3 * PINC + C_GV + h * 64 + 16 * lc);
            const u32x4 vb = *(const u32x4*)(PROJ + tok3 * PINC + C_GV + h * 64 + 16 * lc + 8);
            __syncthreads();
            float loc[8];
            {
                float run = 0.f;
#pragma unroll
                for (int ii = 0; ii < 8; ++ii) {
                    const int i = 8 * cg + ii; float z = ab;
#pragma unroll
                    for (int r = 0; r < 16; ++r) z += xas[i * 16 + r] * au[r];
                    const float la = -softplusf_(-z) * (1.f / 16.f);
                    run += la; loc[ii] = run;
                }
                gsum[cg * 32 + ck] = run;
            }
            __syncthreads();
            {
                float off = 0.f;
#pragma unroll
                for (int g2 = 0; g2 < 8; ++g2) off += (g2 < cg) ? gsum[g2 * 32 + ck] : 0.f;
#pragma unroll
                for (int ii = 0; ii < 8; ++ii) bcum[(8 * cg + ii) * 32 + ck] = loc[ii] + off;
            }
            __syncthreads();
            {
                float qf[8], kf[8], v16[16], qd[8], kd[8];
                unpack8(qv, qf); unpack8(kv, kf); unpack8(va, v16); unpack8(vb, v16 + 8);
#pragma unroll
                for (int j = 0; j < 8; ++j) {
                    const float bc = bcum[li * 32 + 8 * lc + j], bl = bcum[63 * 32 + 8 * lc + j];
                    qd[j] = qf[j] * __expf(bc) * 0.17677669529663687f; kd[j] = kf[j] * __expf(-bc);
                    lds_st16(KeT, (8 * lc + j) * P72 + li * 2, kf[j] * __expf(bl - bc));
                }
                *(u32x4*)(Qd + li * P40 + 16 * lc) = pack8(qd); *(u32x4*)(Kd + li * P40 + 16 * lc) = pack8(kd);
#pragma unroll
                for (int j = 0; j < 16; ++j) lds_st16(Vt, (16 * lc + j) * P72 + li * 2, v16[j]);
            }
            __syncthreads();
            f32x4 yc[2][2];
            {
                f32x4 sc[2][2];
                bf16x8 qfr[2], kfr[2], sfr[2];
#pragma unroll
                for (int m = 0; m < 2; ++m) qfr[m] = LDS_FRAG(Qd, (32 * wr + 16 * m + fr) * P40 + 16 * fq);
#pragma unroll
                for (int n = 0; n < 2; ++n) { kfr[n] = LDS_FRAG(Kd, (32 * wc + 16 * n + fr) * P40 + 16 * fq); sfr[n] = LDS_FRAG(St, (32 * wc + 16 * n + fr) * P40 + 16 * fq); }
#pragma unroll
                for (int m = 0; m < 2; ++m)
#pragma unroll
                    for (int n = 0; n < 2; ++n) {
                        sc[m][n] = MFMA16(kfr[n], qfr[m], ((f32x4){0.f, 0.f, 0.f, 0.f})); yc[m][n] = MFMA16(sfr[n], qfr[m], ((f32x4){0.f, 0.f, 0.f, 0.f}));
                        const int i = 32 * wr + 16 * m + fr, j0 = 32 * wc + 16 * n + 4 * fq;
                        float pv[4];
#pragma unroll
                        for (int r = 0; r < 4; ++r) pv[r] = (i >= j0 + r) ? sc[m][n][r] : 0.f;
                        u32x2 o; o.x = cvt_pk_bf16(pv[0], pv[1]); o.y = cvt_pk_bf16(pv[2], pv[3]);
                        *(u32x2*)(Ps + i * P72 + j0 * 2) = o;
                    }
            }
            __syncthreads();
            f32x4 y[2][2];
#pragma unroll
            for (int m = 0; m < 2; ++m)
#pragma unroll
                for (int n = 0; n < 2; ++n) y[m][n] = yc[m][n];
            {
                float dk[4];
#pragma unroll
                for (int r = 0; r < 4; ++r) dk[r] = __expf(bcum[63 * 32 + 16 * wr + 4 * fq + r]);
#pragma unroll
                for (int n = 0; n < 2; ++n)
#pragma unroll
                    for (int r = 0; r < 4; ++r) sacc[n][r] *= dk[r];
            }
#pragma unroll
            for (int kk = 0; kk < 2; ++kk) {
                bf16x8 pf[2], vf[2];
#pragma unroll
                for (int m = 0; m < 2; ++m) pf[m] = LDS_FRAG(Ps, (32 * wr + 16 * m + fr) * P72 + (32 * kk + 8 * fq) * 2);
#pragma unroll
                for (int n = 0; n < 2; ++n) vf[n] = LDS_FRAG(Vt, (32 * wc + 16 * n + fr) * P72 + (32 * kk + 8 * fq) * 2);
                const bf16x8 kef = LDS_FRAG(KeT, (16 * wr + fr) * P72 + (32 * kk + 8 * fq) * 2);
#pragma unroll
                for (int m = 0; m < 2; ++m)
#pragma unroll
                    for (int n = 0; n < 2; ++n) y[m][n] = MFMA16(vf[n], pf[m], y[m][n]);
#pragma unroll
                for (int n = 0; n < 2; ++n) sacc[n] = MFMA16(kef, vf[n], sacc[n]);
            }
#pragma unroll
            for (int n = 0; n < 2; ++n) {
                u32x2 o; o.x = cvt_pk_bf16(sacc[n][0], sacc[n][1]); o.y = cvt_pk_bf16(sacc[n][2], sacc[n][3]);
                *(u32x2*)(St + (32 * wc + 16 * n + fr) * P40 + (16 * wr + 4 * fq) * 2) = o;
            }
            {
#pragma unroll
                for (int m = 0; m < 2; ++m) {
                    const int i = 32 * wr + 16 * m + fr; const int s = c * 64 + i; const size_t tok = (size_t)b * SEQ + (dir ? (SEQ - 1 - s) : s);
#pragma unroll
                    for (int n = 0; n < 2; ++n) {
                        u32x2 o; o.x = cvt_pk_bf16(y[m][n][0], y[m][n][1]); o.y = cvt_pk_bf16(y[m][n][2], y[m][n][3]);
                        { const int yc_ = h * 64 + 32 * wc + 16 * n + 4 * fq; *(u32x2*)(YF + (dir ? hb_off(tok, YCB + yc_) : tok * 256 + yc_)) = o; }
                    }
                }
            }
        }
        __syncthreads();
    }
}

__device__ __forceinline__ void lru_chain(const Params& p, int l, int b, int hd, int dir, unsigned char* smem) {
    int tid_ = (threadIdx.x & 255); asm volatile("" : "+v"(tid_)); const int tid = tid_, lane = tid & 63, wave = tid >> 6, wr = wave >> 1, wc = wave & 1, fr = lane & 15, fq = lane >> 4;
    unsigned char* W0t = smem; unsigned char* W1t = smem + 9216; unsigned char* Xc = smem + 18432;
    float* Aa = (float*)(smem + 27648); float* Bx = (float*)(smem + 44032);
    const bf16_t* PROJ = WSP(bf16_t, WS_PROJ);
    bf16_t* YF = dir ? WSP(bf16_t, WS_HB) : yt_buf(p, 2); constexpr int YCB = 512;
    const bf16_t* sw = wt_small(p, l) + SW_LRU;
    const int li = tid >> 2, lc = tid & 3;
    float* CW = (float*)(smem + 60416);
    __syncthreads();
    for (int i = tid; i < 320; i += NTHREADS) CW[i] = (i < 256) ? p.in[19][(size_t)l * 1024 + (i >> 6) * 256 + hd * 64 + (i & 63)] : p.in[20][(size_t)l * 256 + hd * 64 + (i & 63)];
    const float* cw = CW + 16 * lc;
    {
        __syncthreads();
        for (int i = tid; i < 2 * 64 * 8; i += NTHREADS) {
            const int g = i >> 9, r = (i >> 3) & 63, ch = i & 7;
            const u32x4 v = *(const u32x4*)(sw + ((size_t)((dir * 2 + g) * 4 + hd)) * 4096 + r * 64 + ch * 8);
            *(u32x4*)((g ? W1t : W0t) + r * P72 + ch * 16) = v;
        }
        float sp8[2][4], b0[2][4], b1[2][4];
#pragma unroll
        for (int n = 0; n < 2; ++n)
#pragma unroll
            for (int r = 0; r < 4; ++r) {
                const int e = hd * 64 + 32 * wc + 16 * n + 4 * fq + r;
                sp8[n][r] = 8.f * softplusf_(-p.in[23][(l * 2 + dir) * 256 + e]);
                b0[n][r] = p.in[22][((l * 2 + dir) * 2 + 0) * 256 + e]; b1[n][r] = p.in[22][((l * 2 + dir) * 2 + 1) * 256 + e];
            }
        float hcar = 0.f;
        u32x4 lxa[4], lxb[4];
#define LRU_LOAD(c) do { const int s_ = (c) * 64 + li; const int t_ = dir ? (SEQ - 1 - s_) : s_; \
            _Pragma("unroll") for (int tap = 0; tap < 4; ++tap) { const int tt = t_ + tap - 2; lxa[tap] = (u32x4){0u, 0u, 0u, 0u}; lxb[tap] = (u32x4){0u, 0u, 0u, 0u}; \
                if (tt >= 0 && tt < SEQ) { const bf16_t* src_ = PROJ + ((size_t)b * SEQ + tt) * PINC + C_LX + hd * 64 + 16 * lc; lxa[tap] = *(const u32x4*)src_; lxb[tap] = *(const u32x4*)(src_ + 8); } } } while (0)
        LRU_LOAD(0);
#pragma unroll 1
        for (int c = 0; c < 64; ++c) {
            {
                float xc[16];
#pragma unroll
                for (int j = 0; j < 16; ++j) xc[j] = cw[256 + j];
#pragma unroll
                for (int tap = 0; tap < 4; ++tap) {
                    float f[16]; unpack8(lxa[tap], f); unpack8(lxb[tap], f + 8);
#pragma unroll
                    for (int j = 0; j < 16; ++j) xc[j] += f[j] * cw[tap * 64 + j];
                }
                *(u32x4*)(Xc + li * P72 + 32 * lc) = pack8(xc); *(u32x4*)(Xc + li * P72 + 32 * lc + 16) = pack8(xc + 8);
            }
            __syncthreads();
            if (c + 1 < 64) LRU_LOAD(c + 1);
            {
                f32x4 g0[2][2], g1[2][2];
#pragma unroll
                for (int m = 0; m < 2; ++m)
#pragma unroll
                    for (int n = 0; n < 2; ++n) { g0[m][n] = (f32x4){0.f, 0.f, 0.f, 0.f}; g1[m][n] = (f32x4){0.f, 0.f, 0.f, 0.f}; }
#pragma unroll
                for (int kk = 0; kk < 2; ++kk) {
                    bf16x8 xf[2], w0f[2], w1f[2];
#pragma unroll
                    for (int m = 0; m < 2; ++m) xf[m] = LDS_FRAG(Xc, (32 * wr + 16 * m + fr) * P72 + (32 * kk + 8 * fq) * 2);
#pragma unroll
                    for (int n = 0; n < 2; ++n) { w0f[n] = LDS_FRAG(W0t, (32 * wc + 16 * n + fr) * P72 + (32 * kk + 8 * fq) * 2); w1f[n] = LDS_FRAG(W1t, (32 * wc + 16 * n + fr) * P72 + (32 * kk + 8 * fq) * 2); }
#pragma unroll
                    for (int m = 0; m < 2; ++m)
#pragma unroll
                        for (int n = 0; n < 2; ++n) { g0[m][n] = MFMA16(w0f[n], xf[m], g0[m][n]); g1[m][n] = MFMA16(w1f[n], xf[m], g1[m][n]); }
                }
#pragma unroll
                for (int m = 0; m < 2; ++m)
#pragma unroll
                    for (int n = 0; n < 2; ++n) {
                        const int i = 32 * wr + 16 * m + fr, e0 = 32 * wc + 16 * n + 4 * fq;
                        const u32x2 xv = *(const u32x2*)(Xc + i * P72 + e0 * 2);
                        const float x4[4] = {bf_lo(xv.x), bf_hi(xv.x), bf_lo(xv.y), bf_hi(xv.y)};
                        f32x4 av, bv;
#pragma unroll
                        for (int r = 0; r < 4; ++r) {
                            const float la = -sp8[n][r] * sigmoidf_(g0[m][n][r] + b0[n][r]);
                            av[r] = __expf(la);
                            const float x2 = 2.f * la;
                            const float em = (x2 > -0.25f) ? -x2 * (1.f + x2 * (0.5f + x2 * (0.16666667f + x2 * (0.041666668f + x2 * (0.0083333338f + x2 * 0.0013888889f))))) : 1.f - __expf(x2);
                            bv[r] = __builtin_amdgcn_sqrtf(em) * sigmoidf_(g1[m][n][r] + b1[n][r]) * x4[r];
                        }
                        *(f32x4*)(Aa + i * 64 + e0) = av; *(f32x4*)(Bx + i * 64 + e0) = bv;
                    }
            }
            __syncthreads();
            if (wave == 0) {
#pragma unroll 8
                for (int i = 0; i < 64; ++i) { hcar = Aa[i * 64 + lane] * hcar + Bx[i * 64 + lane]; Bx[i * 64 + lane] = hcar; }
            }
            __syncthreads();
            {
                const int s = c * 64 + li; const int t = dir ? (SEQ - 1 - s) : s; const size_t tok = (size_t)b * SEQ + t;
                float hv[16];
#pragma unroll
                for (int j = 0; j < 4; ++j) { const f32x4 v = *(const f32x4*)(Bx + li * 64 + 16 * lc + 4 * j); hv[4 * j] = v.x; hv[4 * j + 1] = v.y; hv[4 * j + 2] = v.z; hv[4 * j + 3] = v.w; }
                bf16_t* yo_ = YF + (dir ? hb_off(tok, YCB + hd * 64 + 16 * lc) : tok * 256 + hd * 64 + 16 * lc);
                *(u32x4*)yo_ = pack8(hv); *(u32x4*)(yo_ + 8) = pack8(hv + 8);
            }
        }
#undef LRU_LOAD
    }
    __syncthreads();
}

__device__ __forceinline__ void rwkv_prepass_item(const Params& p, int l, int item, unsigned char* smem) {
    int tid_ = (threadIdx.x & 255); asm volatile("" : "+v"(tid_)); const int tid = tid_, lane = tid & 63, wave = tid >> 6, fr = lane & 15, fq = lane >> 4;
    constexpr int PA = 528;
    unsigned char* XW = smem; unsigned char* XA = smem + 9216; unsigned char* AL = smem + 18432;
    const bf16_t* PROJ = WSP(bf16_t, WS_PROJ);
    const bf16_t* sw = wt_small(p, l);
    const int dir = item & 1; const size_t tok0 = (size_t)(item >> 1) * 64; const int t0 = (int)(tok0 & (SEQ - 1));
    bf16_t* WA = WSP(bf16_t, WS_WA) + (size_t)dir * NTOK * 512;
    float* SC = WSP(float, WS_SC) + (size_t)dir * NTOK * 16;
    const int li = tid >> 2, lc = tid & 3;
    const int t = t0 + li; const size_t tok = tok0 + li;
    const bool hp = dir ? (t < SEQ - 1) : (t > 0);
    const bf16_t* pc = PROJ + tok * PINC; const bf16_t* pp = dir ? pc + PINC : pc - PINC;
    __syncthreads();
    {
        const u32x4 z = {0u, 0u, 0u, 0u};
#pragma unroll
        for (int hf = 0; hf < 2; ++hf) {
            const u32x4 wc_ = *(const u32x4*)(pc + C_WXW + 16 * lc + 8 * hf), wp_ = hp ? *(const u32x4*)(pp + C_WXW + 16 * lc + 8 * hf) : z;
            const u32x4 ac_ = *(const u32x4*)(pc + C_WXA + 16 * lc + 8 * hf), ap_ = hp ? *(const u32x4*)(pp + C_WXA + 16 * lc + 8 * hf) : z;
            float a[8], bq[8], o[8];
            unpack8(wc_, a); unpack8(wp_, bq);
#pragma unroll
            for (int j = 0; j < 8; ++j) o[j] = tanhf_(a[j] + p.in[8][l * 64 + 16 * lc + 8 * hf + j] * (bq[j] - a[j]));
            *(u32x4*)(XW + li * P72 + 32 * lc + 16 * hf) = pack8(o);
            unpack8(ac_, a); unpack8(ap_, bq);
#pragma unroll
            for (int j = 0; j < 8; ++j) o[j] = a[j] + p.in[9][l * 64 + 16 * lc + 8 * hf + j] * (bq[j] - a[j]);
            *(u32x4*)(XA + li * P72 + 32 * lc + 16 * hf) = pack8(o);
        }
    }
    __syncthreads();
#pragma unroll
    for (int which = 0; which < 2; ++which) {
        f32x4 acc[4][4];
#pragma unroll
        for (int m = 0; m < 4; ++m)
#pragma unroll
            for (int n = 0; n < 4; ++n) acc[m][n] = (f32x4){0.f, 0.f, 0.f, 0.f};
        const unsigned char* XS = which ? XA : XW;
        const bf16_t* wsrc = sw + (which ? SW_AUP : SW_WUP) + dir * 16384;
#pragma unroll
        for (int kk = 0; kk < 2; ++kk) {
            bf16x8 xf[4];
#pragma unroll
            for (int m = 0; m < 4; ++m) xf[m] = LDS_FRAG(XS, (16 * m + fr) * P72 + (32 * kk + 8 * fq) * 2);
#pragma unroll
            for (int n = 0; n < 4; ++n) {
                const bf16x8 bw = *(const bf16x8*)(wsrc + (64 * wave + 16 * n + fr) * 64 + 32 * kk + 8 * fq);
#pragma unroll
                for (int m = 0; m < 4; ++m) acc[m][n] = MFMA16(bw, xf[m], acc[m][n]);
            }
        }
#pragma unroll
        for (int n1 = 0; n1 < 2; ++n1) {
            const f32x4 c0a = *(const f32x4*)(p.in[which ? 12 : 10] + (l * 2 + dir) * 256 + 64 * wave + 32 * n1 + 4 * fq);
            const f32x4 c0b = *(const f32x4*)(p.in[which ? 12 : 10] + (l * 2 + dir) * 256 + 64 * wave + 32 * n1 + 16 + 4 * fq);
            const int colw = 64 * wave + 32 * n1 + swz8(fq);
#pragma unroll
            for (int m = 0; m < 4; ++m) {
                float oa[4], ob[4];
#pragma unroll
                for (int r = 0; r < 4; ++r) {
                    const float sa = sigmoidf_(c0a[r] + acc[m][2 * n1][r]), sb = sigmoidf_(c0b[r] + acc[m][2 * n1 + 1][r]);
                    oa[r] = which ? sa : -0.8750387749f * sa; ob[r] = which ? sb : -0.8750387749f * sb;
                }
                u32x2 a, b; a.x = cvt_pk_bf16(oa[0], oa[1]); a.y = cvt_pk_bf16(oa[2], oa[3]); b.x = cvt_pk_bf16(ob[0], ob[1]); b.y = cvt_pk_bf16(ob[2], ob[3]);
                const u32x4 o = pair_swap16(a, b);
                *(u32x4*)(WA + (tok0 + 16 * m + fr) * 512 + which * 256 + colw) = o;
                if (which) *(u32x4*)(AL + (16 * m + fr) * PA + colw * 2) = o;
            }
        }
        __builtin_amdgcn_sched_barrier(0);
    }
    __syncthreads();
    {
        const int col = (tid & 31) * 8;
        float muk[8], mur[8], kkq[8], kaq[8], bnq[8];
        {
            const f32x4 a0 = *(const f32x4*)(p.in[7] + (size_t)l * 768 + 256 + col), a1 = *(const f32x4*)(p.in[7] + (size_t)l * 768 + 256 + col + 4);
            const f32x4 b0 = *(const f32x4*)(p.in[7] + (size_t)l * 768 + col), b1 = *(const f32x4*)(p.in[7] + (size_t)l * 768 + col + 4);
            const f32x4 c0 = *(const f32x4*)(p.in[15] + l * 256 + col), c1 = *(const f32x4*)(p.in[15] + l * 256 + col + 4);
            const f32x4 d0 = *(const f32x4*)(p.in[16] + l * 256 + col), d1 = *(const f32x4*)(p.in[16] + l * 256 + col + 4);
            const f32x4 e0 = *(const f32x4*)(p.in[17] + l * 256 + col), e1 = *(const f32x4*)(p.in[17] + l * 256 + col + 4);
#pragma unroll
            for (int j = 0; j < 4; ++j) { muk[j] = a0[j]; muk[4 + j] = a1[j]; mur[j] = b0[j]; mur[4 + j] = b1[j]; kkq[j] = c0[j]; kkq[4 + j] = c1[j]; kaq[j] = d0[j]; kaq[4 + j] = d1[j]; bnq[j] = e0[j]; bnq[4 + j] = e1[j]; }
        }
        const u32x4 z = {0u, 0u, 0u, 0u};
#pragma unroll 2
        for (int rr = 0; rr < 8; ++rr) {
            const int lt = rr * 8 + (tid >> 5);
            const int tt = t0 + lt; const size_t tk = tok0 + lt;
            const bool hq = dir ? (tt < SEQ - 1) : (tt > 0);
            const bf16_t* qc = PROJ + tk * PINC; const bf16_t* qp = dir ? qc + PINC : qc - PINC;
            const u32x4 kc_ = *(const u32x4*)(qc + C_WK + col), kp_ = hq ? *(const u32x4*)(qp + C_WK + col) : z;
            const u32x4 rc_ = *(const u32x4*)(qc + C_WR + col), rp_ = hq ? *(const u32x4*)(qp + C_WR + col) : z;
            const u32x4 al_ = *(const u32x4*)(AL + lt * PA + col * 2);
            float kc[8], kp[8], rc[8], rp[8], av[8];
            unpack8(kc_, kc); unpack8(kp_, kp); unpack8(rc_, rc); unpack8(rp_, rp); unpack8(al_, av);
            float ss = 0.f, u1 = 0.f, c2 = 0.f, bon = 0.f;
#pragma unroll
            for (int j = 0; j < 8; ++j) {
                const float ks = kc[j] + muk[j] * (kp[j] - kc[j]);
                const float rs = rc[j] + mur[j] * (rp[j] - rc[j]);
                const float kk = ks * kkq[j];
                const float km = ks * (1.f + (av[j] - 1.f) * kaq[j]);
                ss += kk * kk; u1 += kk * av[j] * rs; c2 += km * rs; bon += rs * km * bnq[j];
            }
            ss += dpp_xor1(ss); u1 += dpp_xor1(u1); c2 += dpp_xor1(c2); bon += dpp_xor1(bon);
            ss += dpp_xor2(ss); u1 += dpp_xor2(u1); c2 += dpp_xor2(c2); bon += dpp_xor2(bon);
            ss += dpp_hmirror(ss); u1 += dpp_hmirror(u1); c2 += dpp_hmirror(c2); bon += dpp_hmirror(bon);
            const float inv = 1.f / fmaxf(sqrtf(ss), 1e-12f);
            if ((tid & 7) == 0) *(f32x4*)(SC + (tk * 4 + (col >> 6)) * 4) = (f32x4){inv, inv * u1, c2, bon};
        }
    }
}
__device__ __forceinline__ void phase_rwkv_prepass(const Params& p, int l, unsigned char* smem) {
    constexpr int NIT = (NTOK / 64) * 2;
    for (int k = 0; k < (NIT + NVB_ - 1) / NVB_; ++k) {
        const int it = VBID_ + k * NVB_;
        rwkv_prepass_item(p, l, it < NIT ? it : NIT - 1, smem);
    }
}

constexpr int RW_AR = 0, RW_BK = 18432, RW_UT = 27648, RW_WT = 55296, RW_MM = 82944, RW_LK = 92160, RW_LB = 97280, RW_PC = 105472, RW_CUM = 106496, RW_S0 = 114688, RW_RH = 123904;
constexpr int RHP = 68;
static_assert(RW_RH + 32 * RHP * 4 <= 2 * LDS_MAIN, "rwkv LDS layout");
__device__ __forceinline__ void rwkv_chain(const Params& p, int l, int b, int h, int dir, unsigned char* smem) {
    int tid_ = (threadIdx.x & 255); asm volatile("" : "+v"(tid_)); const int tid = tid_, lane = tid & 63, wave = tid >> 6, wr = wave >> 1, wc = wave & 1, fr = lane & 15, fq = lane >> 4;
    const int vb = VB_;
    unsigned char* BK = smem + RW_BK; unsigned char* S0b = smem + RW_S0;
    float* RH = (float*)(smem + RW_RH);
    float* CUM = (float*)(smem + RW_CUM);
    const bf16_t* PROJ = WSP(bf16_t, WS_PROJ);
    bf16_t* YO = WSP(bf16_t, WS_YRW + (size_t)dir * 16 * MiB);
    const bf16_t* WA = WSP(bf16_t, WS_WA) + (size_t)dir * NTOK * 512;
    const float* SC = WSP(float, WS_SC) + (size_t)dir * NTOK * 16;
#define RW_BUF_AR(j) (smem + RW_AR + ((j) & 1) * 9216)
#define RW_BUF_UT(j) (smem + RW_UT + ((j) % 3) * 9216)
#define RW_BUF_WT(j) (smem + RW_WT + ((j) % 3) * 9216)
#define RW_BUF_PC(j) ((float*)(smem + RW_PC + ((j) % 3) * 256))
#define RW_BUF_MM(j) (smem + RW_MM + ((j) & 1) * 4608)
#define RW_BUF_LK(j) (smem + RW_LK + ((j) & 1) * 2560)
#define RW_BUF_LB(j) ((float*)(smem + RW_LB + ((j) & 1) * 4096))
    if (vb == 0) for (int i = tid; i < 9216 / 4; i += NTHREADS) ((unsigned*)S0b)[i] = 0u;
    if (vb == 0 && tid < 128) RH[(tid >> 2) * RHP + 64 + (tid & 3)] = 0.f;
    __syncthreads();
    if (vb == 1) {
        __builtin_amdgcn_s_setprio(2);
        const int pi = tid >> 3, pg = tid & 7;
        float mu[3][8], kkp[8], kap[8];
        {
            const float* mu_ = p.in[7] + (size_t)l * 3 * 256 + h * 64 + 8 * pg;
#pragma unroll
            for (int j = 0; j < 8; ++j) {
                mu[0][j] = mu_[j]; mu[1][j] = mu_[256 + j]; mu[2][j] = mu_[512 + j];
                kkp[j] = p.in[15][l * 256 + h * 64 + 8 * pg + j]; kap[j] = p.in[16][l * 256 + h * 64 + 8 * pg + j];
            }
        }
        u32x4 rc, kc, vc, rp, kp, vp, omw, aav; f32x4 scv;
#define RWKV_LOAD(c) do { const int s_ = (c) * 32 + pi; const int t_ = dir ? (SEQ - 1 - s_) : s_; const int tp_ = dir ? t_ + 1 : t_ - 1; const size_t tk_ = (size_t)b * SEQ + t_; \
        const bf16_t* pc_ = PROJ + tk_ * PINC; const bf16_t* pp_ = PROJ + ((size_t)b * SEQ + tp_) * PINC; const bool hp_ = (s_ > 0); const u32x4 z_ = {0u, 0u, 0u, 0u}; \
        rc = *(const u32x4*)(pc_ + C_WR + h * 64 + 8 * pg); kc = *(const u32x4*)(pc_ + C_WK + h * 64 + 8 * pg); vc = *(const u32x4*)(pc_ + C_WV + h * 64 + 8 * pg); \
        rp = hp_ ? *(const u32x4*)(pp_ + C_WR + h * 64 + 8 * pg) : z_; kp = hp_ ? *(const u32x4*)(pp_ + C_WK + h * 64 + 8 * pg) : z_; vp = hp_ ? *(const u32x4*)(pp_ + C_WV + h * 64 + 8 * pg) : z_; \
        omw = *(const u32x4*)(WA + tk_ * 512 + h * 64 + 8 * pg); aav = *(const u32x4*)(WA + tk_ * 512 + 256 + h * 64 + 8 * pg); scv = *(const f32x4*)(SC + (tk_ * 4 + h) * 4); } while (0)
        u32x4 rc2, kc2, vc2, rp2, kp2, vp2, omw2, aav2; f32x4 scv2;
#define RWKV_LOAD2(c) do { const int cc_ = (c) < 128 ? (c) : 127; const int s_ = cc_ * 32 + pi; const int t_ = dir ? (SEQ - 1 - s_) : s_; const int tp_ = dir ? t_ + 1 : t_ - 1; const size_t tk_ = (size_t)b * SEQ + t_; \
        const bf16_t* pc_ = PROJ + tk_ * PINC; const bf16_t* pp_ = PROJ + ((size_t)b * SEQ + tp_) * PINC; \
        rc2 = *(const u32x4*)(pc_ + C_WR + h * 64 + 8 * pg); kc2 = *(const u32x4*)(pc_ + C_WK + h * 64 + 8 * pg); vc2 = *(const u32x4*)(pc_ + C_WV + h * 64 + 8 * pg); \
        rp2 = *(const u32x4*)(pp_ + C_WR + h * 64 + 8 * pg); kp2 = *(const u32x4*)(pp_ + C_WK + h * 64 + 8 * pg); vp2 = *(const u32x4*)(pp_ + C_WV + h * 64 + 8 * pg); \
        omw2 = *(const u32x4*)(WA + tk_ * 512 + h * 64 + 8 * pg); aav2 = *(const u32x4*)(WA + tk_ * 512 + 256 + h * 64 + 8 * pg); scv2 = *(const f32x4*)(SC + (tk_ * 4 + h) * 4); } while (0)
        RWKV_LOAD(0);
        RWKV_LOAD2(1);
#define PB_SYNC() do { asm volatile("s_waitcnt lgkmcnt(0)" ::: "memory"); __builtin_amdgcn_s_barrier(); asm volatile("" ::: "memory"); } while (0)
#pragma unroll 1
        for (int it = -2; it < 128; ++it) {
            if (it + 1 >= 0 && it + 1 < 128) {
                const int cj = it + 1;
                unsigned char* AR = RW_BUF_AR(cj); unsigned char* Mm = RW_BUF_MM(cj); unsigned char* LK = RW_BUF_LK(cj); float* LBq = RW_BUF_LB(cj);
                f32x4 macc[2][2];
#pragma unroll
                for (int m = 0; m < 2; ++m)
#pragma unroll
                    for (int n = 0; n < 2; ++n) macc[m][n] = (f32x4){0.f, 0.f, 0.f, 0.f};
#pragma unroll
                for (int kk2 = 0; kk2 < 2; ++kk2) {
                    bf16x8 af[2], bf_[2];
#pragma unroll
                    for (int m = 0; m < 2; ++m) af[m] = LDS_FRAG(AR, (32 * wr + 16 * m + fr) * P72 + (32 * kk2 + 8 * fq) * 2);
#pragma unroll
                    for (int n = 0; n < 2; ++n) bf_[n] = LDS_FRAG(BK, (32 * wc + 16 * n + fr) * P72 + (32 * kk2 + 8 * fq) * 2);
#pragma unroll
                    for (int m = 0; m < 2; ++m)
#pragma unroll
                        for (int n = 0; n < 2; ++n) macc[m][n] = MFMA16(bf_[n], af[m], macc[m][n]);
                }
#pragma unroll
                for (int m = 0; m < 2; ++m)
#pragma unroll
                    for (int n = 0; n < 2; ++n) {
                        const int i = 16 * m + fr, j0 = 16 * n + 4 * fq;
                        float mv[4];
#pragma unroll
                        for (int r = 0; r < 4; ++r) { const bool keep = (wr == 0) ? (j0 + r < i) : (j0 + r <= i); mv[r] = keep ? macc[m][n][r] : 0.f; }
                        if (wr == 0 && wc == 0) {
#pragma unroll
                            for (int r = 0; r < 4; ++r) LBq[i * 32 + r * 8 + (j0 >> 2)] = mv[r];
                        } else if (wr == 0) {
                            u32x2 o; o.x = cvt_pk_bf16(mv[0], mv[1]); o.y = cvt_pk_bf16(mv[2], mv[3]);
                            *(u32x2*)(LK + i * P40 + j0 * 2) = o;
                        } else {
                            u32x2 o; o.x = cvt_pk_bf16(mv[0], mv[1]); o.y = cvt_pk_bf16(mv[2], mv[3]);
                            *(u32x2*)(Mm + i * P72 + (32 * wc + j0) * 2) = o;
                        }
                    }
            }
            PB_SYNC();
            const int cq = it + 2;
            float rs[8], kk[8], ka[8], km[8];
            if (cq < 128) {
                unsigned char* Ut = RW_BUF_UT(cq);
                float a[8], bq[8], ks[8], vs[8], om[8], av[8];
                unpack8(rc, a); unpack8(rp, bq);
#pragma unroll
                for (int j = 0; j < 8; ++j) rs[j] = a[j] + mu[0][j] * (bq[j] - a[j]);
                unpack8(kc, a); unpack8(kp, bq);
#pragma unroll
                for (int j = 0; j < 8; ++j) ks[j] = a[j] + mu[1][j] * (bq[j] - a[j]);
                unpack8(vc, a); unpack8(vp, bq);
#pragma unroll
                for (int j = 0; j < 8; ++j) vs[j] = a[j] + mu[2][j] * (bq[j] - a[j]);
                unpack8(omw, om); unpack8(aav, av);
#pragma unroll
                for (int j = 0; j < 8; ++j) {
                    kk[j] = ks[j] * kkp[j] * scv.x; ka[j] = kk[j] * av[j]; km[j] = ks[j] * (1.f + (av[j] - 1.f) * kap[j]);
                    lds_st16(Ut, (8 * pg + j) * P72 + (32 + ((pi + 8 * pg) & 31)) * 2, vs[j]);
                }
                *(f32x4*)(CUM + pi * 64 + 8 * pg) = (f32x4){om[0], om[1], om[2], om[3]}; *(f32x4*)(CUM + pi * 64 + 8 * pg + 4) = (f32x4){om[4], om[5], om[6], om[7]};
                __builtin_amdgcn_sched_barrier(0);
                rc = rc2; kc = kc2; vc = vc2; rp = rp2; kp = kp2; vp = vp2; omw = omw2; aav = aav2; scv = scv2;
                RWKV_LOAD2(cq + 2);
            }
            PB_SYNC();
            if (cq < 128 && tid < 64) {
                float run = 0.f;
#pragma unroll
                for (int g8 = 0; g8 < 4; ++g8) {
                    float xs[8];
#pragma unroll
                    for (int j = 0; j < 8; ++j) xs[j] = CUM[(8 * g8 + j) * 64 + tid];
#pragma unroll
                    for (int j = 0; j < 8; ++j) { run += xs[j]; xs[j] = run; }
#pragma unroll
                    for (int j = 0; j < 8; ++j) CUM[(8 * g8 + j) * 64 + tid] = xs[j];
                }
            }
            PB_SYNC();
            if (cq < 128) {
                unsigned char* AR = RW_BUF_AR(cq); unsigned char* Wt = RW_BUF_WT(cq); float* PC = RW_BUF_PC(cq);
                float ci[8], cp[8], cl[8];
                {
                    const f32x4 a0 = *(const f32x4*)(CUM + pi * 64 + 8 * pg), a1 = *(const f32x4*)(CUM + pi * 64 + 8 * pg + 4);
                    const f32x4 l0 = *(const f32x4*)(CUM + 31 * 64 + 8 * pg), l1 = *(const f32x4*)(CUM + 31 * 64 + 8 * pg + 4);
                    const int pim = pi > 0 ? pi - 1 : 0;
                    f32x4 p0 = *(const f32x4*)(CUM + pim * 64 + 8 * pg), p1 = *(const f32x4*)(CUM + pim * 64 + 8 * pg + 4);
                    if (pi == 0) { p0 = (f32x4){0.f, 0.f, 0.f, 0.f}; p1 = p0; }
                    ci[0] = a0.x; ci[1] = a0.y; ci[2] = a0.z; ci[3] = a0.w; ci[4] = a1.x; ci[5] = a1.y; ci[6] = a1.z; ci[7] = a1.w;
                    cl[0] = l0.x; cl[1] = l0.y; cl[2] = l0.z; cl[3] = l0.w; cl[4] = l1.x; cl[5] = l1.y; cl[6] = l1.z; cl[7] = l1.w;
                    cp[0] = p0.x; cp[1] = p0.y; cp[2] = p0.z; cp[3] = p0.w; cp[4] = p1.x; cp[5] = p1.y; cp[6] = p1.z; cp[7] = p1.w;
                }
                float ab[8], rb[8], bb[8], kb[8], pcs[8];
#pragma unroll
                for (int j = 0; j < 8; ++j) {
                    const float ei = __builtin_amdgcn_exp2f(ci[j]), en = frcp(ei), ep = __builtin_amdgcn_exp2f(cp[j]), pc = __builtin_amdgcn_exp2f(cl[j]);
                    pcs[j] = pc;
                    ab[j] = -kk[j] * ep; rb[j] = rs[j] * ei; bb[j] = ka[j] * en; kb[j] = km[j] * en;
                    lds_st16(Wt, (8 * pg + j) * P72 + ((pi + 8 * pg) & 31) * 2, bb[j] * pc); lds_st16(Wt, (8 * pg + j) * P72 + (32 + ((pi + 8 * pg) & 31)) * 2, kb[j] * pc);
                }
                if (pi == 31) { *(f32x4*)(PC + 8 * pg) = (f32x4){pcs[0], pcs[1], pcs[2], pcs[3]}; *(f32x4*)(PC + 8 * pg + 4) = (f32x4){pcs[4], pcs[5], pcs[6], pcs[7]}; }
                *(u32x4*)(AR + pi * P72 + 16 * pg) = pack8(ab); *(u32x4*)(AR + (32 + pi) * P72 + 16 * pg) = pack8(rb);
                *(u32x4*)(BK + pi * P72 + 16 * pg) = pack8(bb); *(u32x4*)(BK + (32 + pi) * P72 + 16 * pg) = pack8(kb);
            }
            PB_SYNC();
        }
#undef RWKV_LOAD
#undef RWKV_LOAD2
#undef PB_SYNC
        __builtin_amdgcn_s_setprio(0);
    } else {
#define CB_SYNC() do { asm volatile("s_waitcnt lgkmcnt(0)" ::: "memory"); __builtin_amdgcn_s_barrier(); asm volatile("" ::: "memory"); } while (0)
        f32x4 sacc[2][2];
#pragma unroll
        for (int m = 0; m < 2; ++m)
#pragma unroll
            for (int n = 0; n < 2; ++n) sacc[m][n] = (f32x4){0.f, 0.f, 0.f, 0.f};
#pragma unroll 1
        for (int it = -2; it < 128; ++it) {
            if (it < 0) { CB_SYNC(); CB_SYNC(); CB_SYNC(); CB_SYNC(); continue; }
            const int c = it;
            unsigned char* AR = RW_BUF_AR(c); unsigned char* Ut = RW_BUF_UT(c); unsigned char* Wt = RW_BUF_WT(c); float* PC = RW_BUF_PC(c);
            unsigned char* Mm = RW_BUF_MM(c); unsigned char* LK = RW_BUF_LK(c); float* LBq = RW_BUF_LB(c);
            f32x4 xacc[2][2];
#pragma unroll
            for (int m = 0; m < 2; ++m)
#pragma unroll
                for (int n = 0; n < 2; ++n) xacc[m][n] = (f32x4){0.f, 0.f, 0.f, 0.f};
#pragma unroll
            for (int kk2 = 0; kk2 < 2; ++kk2) {
                bf16x8 af[2], sf[2];
#pragma unroll
                for (int m = 0; m < 2; ++m) af[m] = LDS_FRAG(AR, (32 * wr + 16 * m + fr) * P72 + (32 * kk2 + 8 * fq) * 2);
#pragma unroll
                for (int n = 0; n < 2; ++n) sf[n] = LDS_FRAG(S0b, (32 * wc + 16 * n + fr) * P72 + (32 * kk2 + 8 * fq) * 2);
#pragma unroll
                for (int m = 0; m < 2; ++m)
#pragma unroll
                    for (int n = 0; n < 2; ++n) xacc[m][n] = MFMA16(sf[n], af[m], xacc[m][n]);
            }
            if (wr == 0) {
#pragma unroll
                for (int m = 0; m < 2; ++m) {
                    const bf16x8 lf = LDS_FRAG(LK, (16 * m + fr) * P40 + 16 * fq);
#pragma unroll
                    for (int n = 0; n < 2; ++n) {
                        const bf16x8 vf = LDS_FRAG(Ut, (32 * wc + 16 * n + fr) * P72 + (32 + 8 * ((fq + 2 * n + (fr >> 3)) & 3)) * 2);
                        xacc[m][n] = MFMA16(vf, lf, xacc[m][n]);
                        *(f32x4*)(RH + (16 * m + fr) * RHP + 32 * wc + 16 * n + 4 * fq) = xacc[m][n];
                    }
                }
            }
            CB_SYNC();
            {
                const int vv = 16 * wave + (lane >> 2), q = lane & 3, rcol = (q == 0) ? vv : 64;
                float sreg[8];
#pragma unroll
                for (int t = 0; t < 8; ++t) sreg[t] = 0.f;
                f32x4 la[4], lb[4]; float rhv[4];
#pragma unroll
                for (int s_ = 0; s_ < 4; ++s_) lb[s_] = (f32x4){0.f, 0.f, 0.f, 0.f};
#define P4_LD(slot, i) do { la[slot] = *(const f32x4*)(LBq + (i) * 32 + q * 8); if ((i) > 16) lb[slot] = *(const f32x4*)(LBq + (i) * 32 + q * 8 + 4); rhv[slot] = RH[(i) * RHP + rcol]; } while (0)
#define P4_ROW(i) do { if ((i) + 3 < 32) P4_LD(((i) + 3) & 3, (i) + 3); \
                    const f32x4 l0 = la[(i) & 3], l1 = lb[(i) & 3]; \
                    const float lv[8] = {l0.x, l0.y, l0.z, l0.w, l1.x, l1.y, l1.z, l1.w}; \
                    float part = rhv[(i) & 3]; \
                    _Pragma("unroll") for (int t = 0; t < 8; ++t) { if (4 * t < (i)) part = fmaf(lv[t], sreg[t], part); } \
                    part += dpp_xor1(part); part += dpp_xor2(part); \
                    if (((i) & 3) == q) sreg[(i) >> 2] = part; } while (0)
                __builtin_amdgcn_s_setprio(3);
                P4_LD(0, 0); P4_LD(1, 1); P4_LD(2, 2);
#pragma unroll
                for (int i = 0; i < 22; ++i) P4_ROW(i);
                CB_SYNC();
#pragma unroll
                for (int i = 22; i < 32; ++i) P4_ROW(i);
#undef P4_ROW
#undef P4_LD
#pragma unroll
                for (int t = 0; t < 8; ++t) lds_st16(Ut, vv * P72 + ((4 * t + q + 8 * (vv >> 3)) & 31) * 2, sreg[t]);
            }
            CB_SYNC();
            {
#pragma unroll
                for (int m = 0; m < 2; ++m) {
                    const f32x4 pc4 = *(const f32x4*)(PC + 32 * wr + 16 * m + 4 * fq);
#pragma unroll
                    for (int n = 0; n < 2; ++n) sacc[m][n] = sacc[m][n] * pc4;
                }
#pragma unroll
                for (int kk2 = 0; kk2 < 2; ++kk2) {
                    bf16x8 uf[2], wf[2];
#pragma unroll
                    for (int n = 0; n < 2; ++n) uf[n] = LDS_FRAG(Ut, (32 * wc + 16 * n + fr) * P72 + (32 * kk2 + 8 * ((fq + 2 * n + (fr >> 3)) & 3)) * 2);
#pragma unroll
                    for (int m = 0; m < 2; ++m) wf[m] = LDS_FRAG(Wt, (32 * wr + 16 * m + fr) * P72 + (32 * kk2 + 8 * ((fq + 2 * m + (fr >> 3)) & 3)) * 2);
#pragma unroll
                    for (int m = 0; m < 2; ++m)
#pragma unroll
                        for (int n = 0; n < 2; ++n) sacc[m][n] = MFMA16(wf[m], uf[n], sacc[m][n]);
                    if (wr == 1) {
#pragma unroll
                        for (int m = 0; m < 2; ++m) {
                            const bf16x8 mf = LDS_FRAG(Mm, (16 * m + fr) * P72 + (32 * kk2 + 8 * fq) * 2);
#pragma unroll
                            for (int n = 0; n < 2; ++n) xacc[m][n] = MFMA16(uf[n], mf, xacc[m][n]);
                        }
                    }
                }
#pragma unroll
                for (int m = 0; m < 2; ++m)
#pragma unroll
                    for (int n = 0; n < 2; ++n) {
                        u32x2 o; o.x = cvt_pk_bf16(sacc[m][n][0], sacc[m][n][1]); o.y = cvt_pk_bf16(sacc[m][n][2], sacc[m][n][3]);
                        *(u32x2*)(S0b + (32 * wc + 16 * n + fr) * P72 + (32 * wr + 16 * m + 4 * fq) * 2) = o;
                    }
                if (wr == 1) {
#pragma unroll
                    for (int m = 0; m < 2; ++m) {
                        const int s = c * 32 + 16 * m + fr; const int t = dir ? (SEQ - 1 - s) : s;
                        bf16_t* yo = YO + ((size_t)b * SEQ + t) * 256 + h * 64 + 32 * wc + 4 * fq;
#pragma unroll
                        for (int n = 0; n < 2; ++n) { u32x2 o; o.x = cvt_pk_bf16(xacc[m][n][0], xacc[m][n][1]); o.y = cvt_pk_bf16(xacc[m][n][2], xacc[m][n][3]); *(u32x2*)(yo + 16 * n) = o; }
                    }
                }
            }
            __builtin_amdgcn_s_setprio(0);
            CB_SYNC();
        }
    }
#undef CB_SYNC
    __syncthreads();
}

__device__ __forceinline__ void rwkv_combine_item(const Params& p, int l, int item, unsigned char* smem) {
    int tid_ = (threadIdx.x & 255); asm volatile("" : "+v"(tid_)); const int tid = tid_, lane = tid & 63, wave = tid >> 6, fr = lane & 15, fq = lane >> 4;
    constexpr int PG = 272;
    unsigned char* XG = smem;
    const bf16_t* PROJ = WSP(bf16_t, WS_PROJ);
    const bf16_t* YFw = WSP(bf16_t, WS_YRW); const bf16_t* YBw = WSP(bf16_t, WS_YRW + 16 * MiB);
    const float* SCf = WSP(float, WS_SC); const float* SCb = SCf + (size_t)NTOK * 16;
    bf16_t* HB = WSP(bf16_t, WS_HB);
    const bf16_t* gup = wt_small(p, l) + SW_GUP;
    const size_t tok0 = (size_t)item * 64;
    const int t0 = (int)(tok0 & (SEQ - 1));
    __syncthreads();
    for (int i = tid; i < 64 * 16; i += NTHREADS) {
        const int r = i >> 4, ch = i & 15;
        const u32x4 v = *(const u32x4*)(PROJ + (tok0 + r) * PINC + C_WXG + 8 * ch);
        float f[8]; unpack8(v, f);
#pragma unroll
        for (int j = 0; j < 8; ++j) f[j] = sigmoidf_(f[j]);
        *(u32x4*)(XG + r * PG + 16 * ch) = pack8(f);
    }
    __syncthreads();
    const int h = wave;
    f32x4 G[4][4];
#pragma unroll
    for (int m = 0; m < 4; ++m)
#pragma unroll
        for (int n = 0; n < 4; ++n) G[m][n] = (f32x4){0.f, 0.f, 0.f, 0.f};
#pragma unroll
    for (int kk = 0; kk < 4; ++kk) {
        bf16x8 xf[4], gf[4];
#pragma unroll
        for (int m = 0; m < 4; ++m) xf[m] = LDS_FRAG(XG, (16 * m + fr) * PG + (32 * kk + 8 * fq) * 2);
#pragma unroll
        for (int n = 0; n < 4; ++n) gf[n] = *(const bf16x8*)(gup + (size_t)(64 * h + 16 * n + fr) * 128 + 32 * kk + 8 * fq);
#pragma unroll
        for (int m = 0; m < 4; ++m)
#pragma unroll
            for (int n = 0; n < 4; ++n) G[m][n] = MFMA16(gf[n], xf[m], G[m][n]);
    }
#pragma unroll
    for (int m = 0; m < 4; ++m) {
        const int i = 16 * m + fr; const size_t tok = tok0 + i; const int t = t0 + i;
        f32x4 yv[4]; float s1 = 0.f, s2 = 0.f;
#pragma unroll
        for (int n = 0; n < 4; ++n) {
            const int col = 64 * h + 16 * n + 4 * fq;
            const u32x2 a = *(const u32x2*)(YFw + tok * 256 + col), bq = *(const u32x2*)(YBw + tok * 256 + col);
            f32x4 v = {bf_lo(a.x) + bf_lo(bq.x), bf_hi(a.x) + bf_hi(bq.x), bf_lo(a.y) + bf_lo(bq.y), bf_hi(a.y) + bf_hi(bq.y)};
            yv[n] = v; s1 += (v[0] + v[1]) + (v[2] + v[3]); s2 += (v[0] * v[0] + v[1] * v[1]) + (v[2] * v[2] + v[3] * v[3]);
        }
        s1 += __shfl_xor(s1, 16); s1 += __shfl_xor(s1, 32); s2 += __shfl_xor(s2, 16); s2 += __shfl_xor(s2, 32);
        const float mean = s1 * (1.f / 64.f), var = fmaxf(s2 * (1.f / 64.f) - mean * mean, 0.f), rstd = rsqrtf(var + 64e-5f);
        const float cf = SCf[(tok * 4 + h) * 4 + 3], cbk = SCb[(tok * 4 + h) * 4 + 3];
#pragma unroll
        for (int n = 0; n < 4; ++n) {
            const int col = 64 * h + 16 * n + 4 * fq;
            const u32x2 vc = *(const u32x2*)(PROJ + tok * PINC + C_WV + col);
            u32x2 vp = {0u, 0u}, vn = {0u, 0u};
            if (t > 0) vp = *(const u32x2*)(PROJ + (tok - 1) * PINC + C_WV + col);
            if (t < SEQ - 1) vn = *(const u32x2*)(PROJ + (tok + 1) * PINC + C_WV + col);
            const f32x4 muv = *(const f32x4*)(p.in[7] + (size_t)l * 768 + 512 + col);
            const f32x4 gn = *(const f32x4*)(p.in[18] + l * 256 + col);
            const float c4[4] = {bf_lo(vc.x), bf_hi(vc.x), bf_lo(vc.y), bf_hi(vc.y)};
            const float p4[4] = {bf_lo(vp.x), bf_hi(vp.x), bf_lo(vp.y), bf_hi(vp.y)};
            const float n4[4] = {bf_lo(vn.x), bf_hi(vn.x), bf_lo(vn.y), bf_hi(vn.y)};
            float o4[4];
#pragma unroll
            for (int r = 0; r < 4; ++r) {
                const float vf = c4[r] + muv[r] * (p4[r] - c4[r]), vb = c4[r] + muv[r] * (n4[r] - c4[r]);
                o4[r] = ((yv[n][r] - mean) * rstd * gn[r] + cf * vf + cbk * vb) * G[m][n][r];
            }
            u32x2 o; o.x = cvt_pk_bf16(o4[0], o4[1]); o.y = cvt_pk_bf16(o4[2], o4[3]);
            *(u32x2*)(HB + hb_off(tok, 256 + col)) = o;
        }
    }
}

__device__ __forceinline__ void mix_finalize_item(const Params& p, int l, int item) {
    int tid_ = (threadIdx.x & 255); asm volatile("" : "+v"(tid_)); const int tid = tid_;
    const bf16_t* PROJ = WSP(bf16_t, WS_PROJ);
    bf16_t* HB = WSP(bf16_t, WS_HB);
    const int li = tid >> 2, lc = tid & 3;
    const size_t tok = (size_t)item * 64 + li;
#pragma unroll 2
    for (int h = 0; h < 4; ++h) {
        const int col = 64 * h + 16 * lc;
#pragma unroll
        for (int mx = 0; mx < 3; ++mx) {
            const int ocol = (mx == 0) ? 0 : (mx == 1) ? 768 : 512;
            const bf16_t* yf = yt_buf(p, mx) + tok * 256 + col; bf16_t* yb = HB + hb_off(tok, ocol + col);
            const int gcol = (mx == 0) ? C_RG : (mx == 1) ? C_GOG : C_LG;
            const u32x4 f0 = *(const u32x4*)yf, f1 = *(const u32x4*)(yf + 8), b0 = *(const u32x4*)yb, b1 = *(const u32x4*)(yb + 8);
            const u32x4 g0 = *(const u32x4*)(PROJ + tok * PINC + gcol + col), g1 = *(const u32x4*)(PROJ + tok * PINC + gcol + col + 8);
            float y[16], t2[16], g[16];
            unpack8(f0, y); unpack8(f1, y + 8); unpack8(b0, t2); unpack8(b1, t2 + 8); unpack8(g0, g); unpack8(g1, g + 8);
            float s1 = 0.f, s2 = 0.f;
#pragma unroll
            for (int j = 0; j < 16; ++j) { y[j] += t2[j]; s1 += y[j]; s2 += y[j] * y[j]; }
            float o[16];
            if (mx == 2) {
#pragma unroll
                for (int j = 0; j < 16; ++j) o[j] = y[j] * geluf_(g[j]);
            } else {
                s1 += dpp_xor1(s1); s1 += dpp_xor2(s1); s2 += dpp_xor1(s2); s2 += dpp_xor2(s2);
                const float mean = (mx == 0) ? s1 * (1.f / 64.f) : 0.f;
                const float var = (mx == 0) ? fmaxf(s2 * (1.f / 64.f) - mean * mean, 0.f) : s2 * (1.f / 64.f);
                const float rstd = rsqrtf(var + 1e-6f);
                const float* gn = p.in[mx == 0 ? 6 : 26] + l * 256 + col;
#pragma unroll
                for (int j = 0; j < 16; ++j) o[j] = (y[j] - mean) * rstd * gn[j] * siluf_(g[j]);
            }
            *(u32x4*)yb = pack8(o); *(u32x4*)(yb + 8) = pack8(o + 8);
        }
    }
}

constexpr int SYNCS_RET = 1 + 64 * 3 + 1, SYNCS_GLA = 1 + 64 * 6 + 1, SYNCS_LRU = 2 + 64 * 3 + 1;
__device__ __forceinline__ void phase_mixers(const Params& p, int l, unsigned char* smem) {
    const int vb = VB_;
    for (int job_ = blockIdx.x; job_ < 256; job_ += gridDim.x) {
        const int job = __builtin_amdgcn_readfirstlane(job_);
        if (job < 64) rwkv_chain(p, l, job >> 3, (job >> 1) & 3, job & 1, smem);
        else if (vb == 0) {
            if (job < 128) ret_chain(p, l, (job - 64) >> 3, ((job - 64) >> 1) & 3, job & 1, smem);
            else if (job < 192) gla_chain(p, l, (job - 128) >> 3, ((job - 128) >> 1) & 3, job & 1, smem);
            else lru_chain(p, l, (job - 192) >> 3, ((job - 192) >> 1) & 3, job & 1, smem);
        } else {
            const int n = job < 128 ? SYNCS_RET : job < 192 ? SYNCS_GLA : SYNCS_LRU;
#pragma unroll 1
            for (int i = 0; i < n; ++i) __builtin_amdgcn_s_barrier();
        }
    }
    {
        const int nbk = gridDim.x, first = nbk > 64 ? 64 : 0;
        if ((int)blockIdx.x >= first) conv_expert_items(p, l, smem + vb * LDS_MAIN, ((int)blockIdx.x - first) * 2 + vb, (nbk - first) * 2);
    }
}
__device__ __forceinline__ void phase_rwkv_combine(const Params& p, int l, unsigned char* smem) {
    constexpr int NIT = NTOK / 64;
    for (int k = 0; k < (NIT + NVB_ - 1) / NVB_; ++k) {
        const int it = VBID_ + k * NVB_;
        rwkv_combine_item(p, l, it < NIT ? it : NIT - 1, smem);
        if (it < NIT) mix_finalize_item(p, l, it);
    }
}


constexpr int N_PHASES = 22;
#ifdef DBG_SKIP_MASK
#define ST_EN(k) (!((DBG_SKIP_MASK >> (k)) & 1))
#elif !defined(ONLY_STAGE)
#define ST_EN(k) 1
#else
#define ST_EN(k) ((k) == ONLY_STAGE)
#endif
__device__ __forceinline__ void run_stage(const Params& p, int s, int l, unsigned char* smem_all) {
    unsigned char* smem = smem_all + VB_ * LDS_MAIN;
    switch (s) {
        case 10: phase_p0(p, smem); break;
        case 11: phase_norm(p, 2, p.in[33], DEPTH - 1, smem); break;
        case 0: phase_rotary_table(p); phase_norm(p, l == 0 ? 0 : 1, p.in[2] + l * D, l - 1, smem); break;
        case 1: phase_gemm(p, G_PROJ, l, smem_all); break;
        case 9: phase_rwkv_prepass(p, l, smem); break;
        case 2: phase_mixers(p, l, smem_all); break;
        case 3: phase_rwkv_combine(p, l, smem); break;
        case 4: phase_gemm(p, G_OUT, l, smem_all); break;
        case 5: phase_ffnnorm_router(p, l, smem); break;
        case 6: phase_topk(p, smem_all); break;
        case 7: phase_gemm(p, G_MOE1, l, smem_all); break;
        default: phase_gemm(p, G_MOE2, l, smem_all); break;
    }
}
__device__ __forceinline__ int stage_of_phase(int ph) { if (ph == 0) return 10; if (ph == N_PHASES - 1) return 11; const int q = (ph - 1) % 10; return q == 2 ? 9 : (q < 2 ? q : q - 1); }
__device__ __forceinline__ int layer_of_phase(int ph) { return ph >= 11 ? 1 : 0; }

__global__ void __launch_bounds__(BTHREADS, 2) hybrid_fwd(Params p) {
    extern __shared__ __attribute__((aligned(16))) unsigned char smem[];
    volatile unsigned* st = (volatile unsigned*)(smem + 2 * LDS_MAIN);
    if (threadIdx.x < 16) st[threadIdx.x] = 0u;
    __syncthreads();
    unsigned* ctl = (unsigned*)(p.ws + WS_CTL);
    XcdBarrier bar; bar.bar = ctl + CW_BAR; bar.x = 0; bar.st = st;
#if ONE_LAUNCH
    bar = xcd_barrier_post(ctl + CW_BAR, st);
#if defined(DBG_DUP_MASK)
#define DUP_(S, L) if ((DBG_DUP_MASK >> (S)) & 1) { xcd_barrier(bar); run_stage(p, (S), (L), smem); }
#elif defined(DBG_DUP_STAGE)
#define DUP_(S, L) if ((S) == DBG_DUP_STAGE) { xcd_barrier(bar); run_stage(p, (S), (L), smem); }
#else
#define DUP_(S, L)
#endif
#define RUN_(S, L) { run_stage(p, (S), (L), smem); DUP_(S, L) xcd_barrier(bar); }
#define LAYER_(L) RUN_(0, L) RUN_(1, L) RUN_(9, L) RUN_(2, L) RUN_(3, L) RUN_(4, L) RUN_(5, L) RUN_(6, L) RUN_(7, L) RUN_(8, L)
    run_stage(p, 10, 0, smem);
    LAYER_(0)
    LAYER_(1)
    run_stage(p, 11, 1, smem);
#else
#pragma unroll 1
    for (int ph = p.phase_lo; ph < p.phase_hi; ++ph) run_stage(p, stage_of_phase(ph), __builtin_amdgcn_readfirstlane(layer_of_phase(ph)), smem);
#endif
}

extern "C" void kernel_launch(void* const* d_in, const int* in_sizes, int n_in, void* d_out, int out_size, void* d_ws, size_t ws_size, hipStream_t stream) {
    static int grid = 0;
    if (grid == 0) {
        if (n_in != 34 || out_size != NTOK * D || ws_size < WS_END) { fprintf(stderr, "kernel_launch: unexpected shapes (n_in %d out %d ws %zu need %zu)\n", n_in, out_size, ws_size, (size_t)WS_END); grid = -1; return; }
        int dev = 0, cus = 0, per_cu = 0;
        hipGetDevice(&dev);
        hipDeviceGetAttribute(&cus, hipDeviceAttributeMultiprocessorCount, dev);
        hipFuncSetAttribute((const void*)hybrid_fwd, hipFuncAttributeMaxDynamicSharedMemorySize, LDS_BYTES);
        hipOccupancyMaxActiveBlocksPerMultiprocessor(&per_cu, (const void*)hybrid_fwd, BTHREADS, LDS_BYTES);
        if (per_cu < 1) { fprintf(stderr, "kernel_launch: occupancy query says %d blocks/CU\n", per_cu); per_cu = 1; }
        if (per_cu > 1) per_cu = 1;
        grid = cus * per_cu;
        (void)hipGetLastError();
    }
    if (grid < 0) return;
    hipMemsetAsync((char*)d_ws + WS_CTL, 0, 1 * MiB, stream);
    Params p{};
    for (int i = 0; i < 34; ++i) p.in[i] = (const float*)d_in[i];
    p.out = (float*)d_out; p.ws = (unsigned char*)d_ws;
#if ONE_LAUNCH
    p.phase_lo = 0; p.phase_hi = N_PHASES;
    void* args[] = {&p};
    hipError_t e = hipLaunchCooperativeKernel((const void*)hybrid_fwd, dim3(grid), dim3(BTHREADS), args, LDS_BYTES, stream);
    if (e != hipSuccess) fprintf(stderr, "cooperative launch failed: %s (grid %d)\n", hipGetErrorString(e), grid);
#else
    for (int ph = 0; ph < N_PHASES; ++ph) {
        p.phase_lo = ph; p.phase_hi = ph + 1;
        hipLaunchKernelGGL(hybrid_fwd, dim3(grid), dim3(BTHREADS), LDS_BYTES, stream, p);
    }
#endif
}
```
